# Optimizing an MI355X kernel written in HIP

```python
import math
import jax
import jax.numpy as jnp
from jax import lax
import numpy as np

D_MODEL = 2048
BATCH = 2
SEQ = 4096
DEPTH = 2
DEC_BATCH = 8
DEC_SEQ = 8
PAST_LEN = 16384
PAGE_SIZE = 128

MIX_WIDTH = D_MODEL
ATTN_WIDTH = MIX_WIDTH // 2
CONV_DIM = MIX_WIDTH - ATTN_WIDTH
HEAD_DIM = 64
N_HEADS = ATTN_WIDTH // HEAD_DIM
KV_HEADS = 4
Q_PER_KV = N_HEADS // KV_HEADS
KV_WIDTH = KV_HEADS * HEAD_DIM
N_BRANCH = 3
BLOCK = 64
N_SEL = 16
WINDOW = 512
CONV_W = 3
D_FF = 4 * D_MODEL
ALPHA = (2.0 * DEPTH) ** 0.25
BETA = (8.0 * DEPTH) ** -0.25
LN_EPS = 1e-5
Q_BLOCK = 32
NEG = -1e30
FORCED_SCORE = 1e9
PROJ_SPLITS = (ATTN_WIDTH, 2 * KV_WIDTH, 2 * KV_WIDTH, 2 * KV_WIDTH, N_HEADS * N_BRANCH, CONV_DIM, CONV_DIM, CONV_DIM)
PROJ_WIDTH = sum(PROJ_SPLITS)

kernel_name = 'nsa_shortconv_hymba_deepnorm_step'


def layer_norm(x, g, b):
    xf = x.astype(jnp.float32)
    mu = jnp.mean(xf, axis=-1, keepdims=True)
    var = jnp.mean(jnp.square(xf - mu), axis=-1, keepdims=True)
    return ((xf - mu) * lax.rsqrt(var + LN_EPS) * g + b).astype(x.dtype)


def masked_softmax(s, mask):
    s = jnp.where(mask, s.astype(jnp.float32), NEG)
    m = jnp.max(s, axis=-1, keepdims=True)
    e = jnp.where(mask, jnp.exp(s - m), 0.0)
    return e / jnp.maximum(jnp.sum(e, axis=-1, keepdims=True), 1e-30)


def in_projection(h, w_in):
    u = jnp.einsum('btd,de->bte', h, w_in)
    B, T, _ = u.shape
    q, kv_c, kv_s, kv_w, g, xin, bg, cg = jnp.split(u, np.cumsum(PROJ_SPLITS)[:-1].tolist(), axis=-1)
    q = q.reshape(B, T, KV_HEADS, Q_PER_KV, HEAD_DIM)
    kv_c = kv_c.reshape(B, T, 2, KV_HEADS, HEAD_DIM)
    kv_s = kv_s.reshape(B, T, 2, KV_HEADS, HEAD_DIM)
    kv_w = kv_w.reshape(B, T, 2, KV_HEADS, HEAD_DIM)
    gates = jax.nn.sigmoid(g.reshape(B, T, KV_HEADS, Q_PER_KV, N_BRANCH))
    return q, kv_c, kv_s, kv_w, gates, xin, bg, cg


def nsa_attention(q, q_pos0, kv_cmp, kv_slc, kv_win, win_pos0, gates, w_cmp_k, w_cmp_v):
    B, Tq = q.shape[0], q.shape[1]
    L = kv_cmp.shape[1]
    scale = HEAD_DIM ** -0.5
    q_pos = q_pos0 + jnp.arange(Tq, dtype=jnp.int32)
    n_blk = -(-L // BLOCK)
    pad = n_blk * BLOCK - L
    blk = jnp.arange(n_blk, dtype=jnp.int32)
    pad_cfg = ((0, 0), (0, pad), (0, 0), (0, 0), (0, 0))
    kvc = jnp.pad(kv_cmp, pad_cfg).reshape(B, n_blk, BLOCK, 2, KV_HEADS, HEAD_DIM)
    k_cmp = jnp.einsum('bnlgd,ld->bngd', kvc[:, :, :, 0], w_cmp_k)
    v_cmp = jnp.einsum('bnlgd,ld->bngd', kvc[:, :, :, 1], w_cmp_v)
    s_c = jnp.einsum('bqgrd,bngd->bgrqn', q, k_cmp) * scale
    cmask = (blk[None, :] * BLOCK + BLOCK - 1) <= q_pos[:, None]
    p_c = masked_softmax(s_c, cmask)
    o_cmp = jnp.einsum('bgrqn,bngd->bqgrd', p_c.astype(v_cmp.dtype), v_cmp)
    cur = q_pos // BLOCK
    imp = jnp.sum(p_c, axis=2)
    forced = (blk[None, :] == 0) | (blk[None, :] == cur[:, None]) | (blk[None, :] == cur[:, None] - 1)
    cand = blk[None, :] <= cur[:, None]
    score = jnp.where(forced, FORCED_SCORE, jnp.where(cand, imp, -FORCED_SCORE))
    n_sel = min(N_SEL, n_blk)
    _, sel = lax.top_k(score, n_sel)
    qc = math.gcd(Tq, Q_BLOCK)
    n_chunk = Tq // qc
    kvs_blk = jnp.pad(kv_slc, pad_cfg).reshape(B, n_blk, BLOCK, 2, KV_HEADS, HEAD_DIM).transpose(0, 4, 1, 2, 3, 5)
    kvw_pad = jnp.pad(kv_win, ((0, 0), (WINDOW - 1, 0), (0, 0), (0, 0), (0, 0)))
    q_chunks = q.reshape(B, n_chunk, qc, KV_HEADS, Q_PER_KV, HEAD_DIM).swapaxes(0, 1)
    sel_chunks = sel.reshape(B, KV_HEADS, n_chunk, qc, n_sel).transpose(2, 0, 1, 3, 4)
    pos_chunks = q_pos.reshape(n_chunk, qc)
    b_idx = jnp.arange(B)[:, None, None, None]
    g_idx = jnp.arange(KV_HEADS)[None, :, None, None]
    offs = jnp.arange(BLOCK, dtype=jnp.int32)
    n_wk = WINDOW - 1 + qc
    w_offs = jnp.arange(n_wk, dtype=jnp.int32)

    def chunk_fn(args):
        qb, sb, pb = args
        kv_sel = kvs_blk[b_idx, g_idx, sb]
        k_pos = sb[..., None] * BLOCK + offs
        smask = (k_pos <= pb[None, None, :, None, None]).reshape(B, KV_HEADS, 1, qc, n_sel * BLOCK)
        s_s = jnp.einsum('bqgrd,bgqnkd->bgrqnk', qb, kv_sel[..., 0, :]) * scale
        p_s = masked_softmax(s_s.reshape(B, KV_HEADS, Q_PER_KV, qc, n_sel * BLOCK), smask)
        p_s = p_s.reshape(B, KV_HEADS, Q_PER_KV, qc, n_sel, BLOCK).astype(kv_sel.dtype)
        o_s = jnp.einsum('bgrqnk,bgqnkd->bqgrd', p_s, kv_sel[..., 1, :])
        start = pb[0] - win_pos0
        kvw = lax.dynamic_slice_in_dim(kvw_pad, start, n_wk, axis=1)
        w_pos = pb[0] - (WINDOW - 1) + w_offs
        delta = pb[:, None] - w_pos[None, :]
        wmask = (delta >= 0) & (delta < WINDOW) & (w_pos[None, :] >= win_pos0)
        s_w = jnp.einsum('bqgrd,bkgd->bgrqk', qb, kvw[:, :, 0]) * scale
        p_w = masked_softmax(s_w, wmask).astype(kvw.dtype)
        o_w = jnp.einsum('bgrqk,bkgd->bqgrd', p_w, kvw[:, :, 1])
        return o_s, o_w

    o_sel, o_win = lax.map(chunk_fn, (q_chunks, sel_chunks, pos_chunks))
    o_sel = o_sel.swapaxes(0, 1).reshape(B, Tq, KV_HEADS, Q_PER_KV, HEAD_DIM)
    o_win = o_win.swapaxes(0, 1).reshape(B, Tq, KV_HEADS, Q_PER_KV, HEAD_DIM)
    return gates[..., 0:1] * o_cmp + gates[..., 1:2] * o_sel + gates[..., 2:3] * o_win


def short_conv(xin, bg, cg, prev, conv_w):
    z = cg * xin
    T = z.shape[1]
    zp = jnp.concatenate([prev.astype(z.dtype), z], axis=1)
    y = conv_w[CONV_W - 1] * zp[:, CONV_W - 1:CONV_W - 1 + T]
    for j in range(CONV_W - 1):
        y = y + conv_w[j] * zp[:, j:j + T]
    return bg * y, zp[:, -(CONV_W - 1):]


def gather_pages(pool, page_table):
    pages = pool[page_table]
    return pages.reshape(page_table.shape[0], -1, *pool.shape[2:])


def hybrid_layer(x, past, w_in, w_cmp_k, w_cmp_v, conv_w, w_out, ln1_g, ln1_b, w_mlp1, w_mlp2, ln2_g, ln2_b):
    B, T, _ = x.shape
    q, kv_c, kv_s, kv_w, gates, xin, bg, cg = in_projection(x, w_in)
    if past is None:
        q_pos0 = 0
        kc_all, ks_all, kw_all = kv_c, kv_s, kv_w
        win_pos0 = 0
        conv_prev = jnp.zeros((B, CONV_W - 1, CONV_DIM), x.dtype)
        win_keep = min(WINDOW, T)
    else:
        pc, ps, pw, pconv = past
        q_pos0 = pc.shape[1]
        kc_all = jnp.concatenate([pc.astype(kv_c.dtype), kv_c], axis=1)
        ks_all = jnp.concatenate([ps.astype(kv_s.dtype), kv_s], axis=1)
        kw_all = jnp.concatenate([pw.astype(kv_w.dtype), kv_w], axis=1)
        win_pos0 = q_pos0 - pw.shape[1]
        conv_prev = pconv
        win_keep = pw.shape[1]
    attn = nsa_attention(q, q_pos0, kc_all, ks_all, kw_all, win_pos0, gates, w_cmp_k, w_cmp_v)
    conv_out, conv_state = short_conv(xin, bg, cg, conv_prev, conv_w)
    mix = jnp.einsum('bte,ed->btd', jnp.concatenate([attn.reshape(B, T, ATTN_WIDTH).astype(conv_out.dtype), conv_out], axis=-1), w_out)
    h = layer_norm(ALPHA * x + mix, ln1_g, ln1_b)
    f = jnp.einsum('btf,fd->btd', jnp.square(jax.nn.relu(jnp.einsum('btd,df->btf', h, w_mlp1))), w_mlp2)
    y = layer_norm(ALPHA * h + f, ln2_g, ln2_b)
    return y, kv_c, kv_s, kw_all[:, -win_keep:], conv_state


def setup_inputs(seed: int = 0) -> dict:
    key = jax.random.key(seed)
    ks = jax.random.split(key, 20)
    nrm = jax.random.normal
    f32 = jnp.float32
    n_pages = PAST_LEN // PAGE_SIZE
    n_pool = (DEC_BATCH * n_pages * 5) // 4
    win_buf = min(WINDOW, PAST_LEN)
    page_table = jax.random.permutation(ks[6], n_pool)[:DEC_BATCH * n_pages].reshape(DEC_BATCH, n_pages).astype(jnp.int32)
    return {
        'x_prompt': nrm(ks[0], (BATCH, SEQ, D_MODEL), f32),
        'x_sample': nrm(ks[1], (DEC_BATCH, DEC_SEQ, D_MODEL), f32),
        'cache_cmp': nrm(ks[2], (DEPTH, n_pool, PAGE_SIZE, 2, KV_HEADS, HEAD_DIM), f32),
        'cache_slc': nrm(ks[3], (DEPTH, n_pool, PAGE_SIZE, 2, KV_HEADS, HEAD_DIM), f32),
        'cache_win': nrm(ks[4], (DEPTH, DEC_BATCH, win_buf, 2, KV_HEADS, HEAD_DIM), f32),
        'state_conv': nrm(ks[5], (DEPTH, DEC_BATCH, CONV_W - 1, CONV_DIM), f32),
        'page_table': page_table,
        'w_in': nrm(ks[7], (DEPTH, D_MODEL, PROJ_WIDTH), f32) * D_MODEL ** -0.5,
        'w_cmp_k': (1.0 + 0.1 * nrm(ks[8], (DEPTH, BLOCK, HEAD_DIM), f32)) / BLOCK,
        'w_cmp_v': (1.0 + 0.1 * nrm(ks[9], (DEPTH, BLOCK, HEAD_DIM), f32)) / BLOCK,
        'conv_w': nrm(ks[10], (DEPTH, CONV_W, CONV_DIM), f32) * CONV_W ** -0.5,
        'w_out': nrm(ks[11], (DEPTH, MIX_WIDTH, D_MODEL), f32) * (MIX_WIDTH ** -0.5 * BETA),
        'ln1_g': 1.0 + 0.02 * nrm(ks[12], (DEPTH, D_MODEL), f32),
        'ln1_b': 0.02 * nrm(ks[13], (DEPTH, D_MODEL), f32),
        'w_mlp1': nrm(ks[14], (DEPTH, D_MODEL, D_FF), f32) * D_MODEL ** -0.5,
        'w_mlp2': nrm(ks[15], (DEPTH, D_FF, D_MODEL), f32) * (D_FF ** -0.5 * BETA),
        'ln2_g': 1.0 + 0.02 * nrm(ks[16], (DEPTH, D_MODEL), f32),
        'ln2_b': 0.02 * nrm(ks[17], (DEPTH, D_MODEL), f32),
    }


def reference(x_prompt, x_sample, cache_cmp, cache_slc, cache_win, state_conv, page_table, w_in, w_cmp_k, w_cmp_v, conv_w, w_out, ln1_g, ln1_b, w_mlp1, w_mlp2, ln2_g, ln2_b):
    yp, ys = x_prompt, x_sample
    cmp_p, slc_p, win_p, conv_p = [], [], [], []
    cmp_s, slc_s, win_s, conv_s = [], [], [], []
    for l in range(DEPTH):
        params = (w_in[l], w_cmp_k[l], w_cmp_v[l], conv_w[l], w_out[l], ln1_g[l], ln1_b[l], w_mlp1[l], w_mlp2[l], ln2_g[l], ln2_b[l])
        yp, c1, s1, w1, v1 = hybrid_layer(yp, None, *params)
        past = (gather_pages(cache_cmp[l], page_table), gather_pages(cache_slc[l], page_table), cache_win[l], state_conv[l])
        ys, c2, s2, w2, v2 = hybrid_layer(ys, past, *params)
        cmp_p.append(c1); slc_p.append(s1); win_p.append(w1); conv_p.append(v1)
        cmp_s.append(c2); slc_s.append(s2); win_s.append(w2); conv_s.append(v2)
    return (yp, ys, jnp.stack(cmp_p), jnp.stack(slc_p), jnp.stack(win_p), jnp.stack(conv_p), jnp.stack(cmp_s), jnp.stack(slc_s), jnp.stack(win_s), jnp.stack(conv_s))
```

```cpp
#include <hip/hip_runtime.h>
#include <cstdint>
#include <cstdio>

namespace {
constexpr int D_MODEL = 2048, SEQ = 4096, DEPTH = 2;
constexpr int D_FF = 8192, PROJ = 5680;
constexpr int C_Q = 0, C_KVC = 1024, C_KVS = 1536, C_KVW = 2048, C_G = 2560, C_XIN = 2608, C_BG = 3632, C_CG = 4656;
constexpr int MP = 8192, MS = 64, M = MP + MS;
constexpr int NBLK_P = 64, NBLK_S = 257;
constexpr float ALPHA = 1.41421356237309515f;
constexpr float LN_EPS = 1e-5f;
constexpr size_t O0 = 0, O1 = 16777216, O2 = 16908288, O3 = 25296896, O4 = 33685504, O5 = 34734080, O6 = 34742272, O7 = 34807808, O8 = 34873344, O9 = 39067648, OEND = 39100416;

template <int EPI>
__global__ __launch_bounds__(256) void gemm_f32(const float* __restrict__ A, int lda, const float* __restrict__ B, int ldb, float* __restrict__ C, int ldc, int Mr, int N, int K) {
    __shared__ float As[16][132];
    __shared__ float Bs[16][132];
    const int tid = threadIdx.x, tx = tid & 15, ty = tid >> 4;
    const int m0 = blockIdx.y * 128, n0 = blockIdx.x * 128;
    float acc[8][8];
#pragma unroll
    for (int i = 0; i < 8; ++i)
#pragma unroll
        for (int j = 0; j < 8; ++j) acc[i][j] = 0.f;
    const int arow = tid >> 1, akk = (tid & 1) * 8;
    const int bk = tid >> 4, bn = (tid & 15) * 8;
    for (int k0 = 0; k0 < K; k0 += 16) {
        float4 a0 = make_float4(0, 0, 0, 0), a1 = a0, b0 = a0, b1 = a0;
        if (m0 + arow < Mr) { const float* ap = A + (size_t)(m0 + arow) * lda + k0 + akk; a0 = *(const float4*)ap; a1 = *(const float4*)(ap + 4); }
        { const float* bp = B + (size_t)(k0 + bk) * ldb + n0 + bn; if (n0 + bn + 3 < N) b0 = *(const float4*)bp; if (n0 + bn + 7 < N) b1 = *(const float4*)(bp + 4); }
        __syncthreads();
        As[akk + 0][arow] = a0.x; As[akk + 1][arow] = a0.y; As[akk + 2][arow] = a0.z; As[akk + 3][arow] = a0.w;
        As[akk + 4][arow] = a1.x; As[akk + 5][arow] = a1.y; As[akk + 6][arow] = a1.z; As[akk + 7][arow] = a1.w;
        *(float4*)&Bs[bk][bn] = b0; *(float4*)&Bs[bk][bn + 4] = b1;
        __syncthreads();
#pragma unroll
        for (int kk = 0; kk < 16; ++kk) {
            float a[8], b[8];
            const float4 av0 = *(const float4*)&As[kk][ty * 4], av1 = *(const float4*)&As[kk][64 + ty * 4];
            const float4 bv0 = *(const float4*)&Bs[kk][tx * 4], bv1 = *(const float4*)&Bs[kk][64 + tx * 4];
            a[0] = av0.x; a[1] = av0.y; a[2] = av0.z; a[3] = av0.w; a[4] = av1.x; a[5] = av1.y; a[6] = av1.z; a[7] = av1.w;
            b[0] = bv0.x; b[1] = bv0.y; b[2] = bv0.z; b[3] = bv0.w; b[4] = bv1.x; b[5] = bv1.y; b[6] = bv1.z; b[7] = bv1.w;
#pragma unroll
            for (int i = 0; i < 8; ++i)
#pragma unroll
                for (int j = 0; j < 8; ++j) acc[i][j] = fmaf(a[i], b[j], acc[i][j]);
        }
    }
#pragma unroll
    for (int i = 0; i < 8; ++i) {
        const int r = m0 + (i < 4 ? ty * 4 + i : 64 + ty * 4 + (i - 4));
        if (r >= Mr) continue;
#pragma unroll
        for (int jh = 0; jh < 2; ++jh) {
            const int c = n0 + jh * 64 + tx * 4;
            if (c + 3 < N) {
                float4 v = make_float4(acc[i][jh * 4 + 0], acc[i][jh * 4 + 1], acc[i][jh * 4 + 2], acc[i][jh * 4 + 3]);
                if (EPI == 1) { v.x = v.x > 0 ? v.x * v.x : 0.f; v.y = v.y > 0 ? v.y * v.y : 0.f; v.z = v.z > 0 ? v.z * v.z : 0.f; v.w = v.w > 0 ? v.w * v.w : 0.f; }
                *(float4*)(C + (size_t)r * ldc + c) = v;
            }
        }
    }
}

__device__ __forceinline__ float wave_sum(float v) {
#pragma unroll
    for (int o = 1; o < 64; o <<= 1) v += __shfl_xor(v, o);
    return v;
}
__device__ __forceinline__ float wave_max(float v) {
#pragma unroll
    for (int o = 1; o < 64; o <<= 1) v = fmaxf(v, __shfl_xor(v, o));
    return v;
}

struct LayerP {
    const float* U;
    const float* cache_cmp;
    const float* cache_slc;
    const float* cache_win;
    const float* state_conv;
    const int* page_table;
    const float* w_cmp_k;
    const float* w_cmp_v;
    const float* conv_w;
    float* kcmp_p;
    float* kcmp_s;
    float* A2;
    float* out;
    int layer;
    int pad;
};

__device__ __forceinline__ const float* cmp_row(const LayerP& P, int path, int b, int pos) {
    if (!path) return P.U + (size_t)(b * SEQ + pos) * PROJ + C_KVC;
    if (pos < 16384) return P.cache_cmp + ((size_t)P.page_table[b * 128 + (pos >> 7)] * 128 + (pos & 127)) * 512;
    return P.U + (size_t)(MP + b * 8 + (pos - 16384)) * PROJ + C_KVC;
}
__device__ __forceinline__ const float* slc_row(const LayerP& P, int path, int b, int pos) {
    if (!path) return P.U + (size_t)(b * SEQ + pos) * PROJ + C_KVS;
    if (pos < 16384) return P.cache_slc + ((size_t)P.page_table[b * 128 + (pos >> 7)] * 128 + (pos & 127)) * 512;
    return P.U + (size_t)(MP + b * 8 + (pos - 16384)) * PROJ + C_KVS;
}
__device__ __forceinline__ const float* win_row(const LayerP& P, int path, int b, int pos) {
    if (!path) return P.U + (size_t)(b * SEQ + pos) * PROJ + C_KVW;
    const int i = pos - 15872;
    if (i < 512) return P.cache_win + ((size_t)b * 512 + i) * 512;
    return P.U + (size_t)(MP + b * 8 + (i - 512)) * PROJ + C_KVW;
}

__global__ __launch_bounds__(256) void scatter_kernel(LayerP P) {
    const int l = P.layer;
    const size_t gid = (size_t)blockIdx.x * 256 + threadIdx.x, gs = (size_t)gridDim.x * 256;
    float* out = P.out;
    for (size_t i = gid; i < (size_t)MP * 512; i += gs) { const int row = (int)(i >> 9), j = (int)(i & 511);
        out[O2 + (size_t)l * MP * 512 + i] = P.U[(size_t)row * PROJ + C_KVC + j];
        out[O3 + (size_t)l * MP * 512 + i] = P.U[(size_t)row * PROJ + C_KVS + j]; }
    for (size_t i = gid; i < (size_t)2 * 512 * 512; i += gs) { const int b = (int)(i >> 18), r = (int)((i >> 9) & 511), j = (int)(i & 511);
        out[O4 + (size_t)l * 2 * 512 * 512 + i] = P.U[(size_t)(b * SEQ + 3584 + r) * PROJ + C_KVW + j]; }
    for (size_t i = gid; i < (size_t)MS * 512; i += gs) { const int row = (int)(i >> 9), j = (int)(i & 511);
        out[O6 + (size_t)l * MS * 512 + i] = P.U[(size_t)(MP + row) * PROJ + C_KVC + j];
        out[O7 + (size_t)l * MS * 512 + i] = P.U[(size_t)(MP + row) * PROJ + C_KVS + j]; }
    for (size_t i = gid; i < (size_t)8 * 512 * 512; i += gs) { const int b = (int)(i >> 18), r = (int)((i >> 9) & 511), j = (int)(i & 511);
        float v;
        if (r < 504) v = P.cache_win[((size_t)b * 512 + r + 8) * 512 + j]; else v = P.U[(size_t)(MP + b * 8 + (r - 504)) * PROJ + C_KVW + j];
        out[O8 + (size_t)l * 8 * 512 * 512 + i] = v; }
}

__global__ __launch_bounds__(512) void cmp_kernel(LayerP P) {
    const int bid = blockIdx.x; int path, b, n;
    if (bid < 2 * NBLK_P) { path = 0; b = bid / NBLK_P; n = bid % NBLK_P; } else { path = 1; b = (bid - 2 * NBLK_P) / NBLK_S; n = (bid - 2 * NBLK_P) % NBLK_S; }
    const int c = threadIdx.x, kv = c >> 8, d = c & 63;
    const int L = path ? 16392 : 4096;
    const float* w = kv ? P.w_cmp_v : P.w_cmp_k;
    float acc = 0.f;
    for (int l = 0; l < 64; ++l) { const int pos = n * 64 + l; if (pos < L) acc = fmaf(cmp_row(P, path, b, pos)[c], w[l * 64 + d], acc); }
    (path ? P.kcmp_s + ((size_t)b * NBLK_S + n) * 512 : P.kcmp_p + ((size_t)b * NBLK_P + n) * 512)[c] = acc;
}

__global__ __launch_bounds__(256) void conv_kernel(LayerP P) {
    const int l = P.layer;
    const size_t gid = (size_t)blockIdx.x * 256 + threadIdx.x, gs = (size_t)gridDim.x * 256;
    for (size_t i = gid; i < (size_t)M * 1024; i += gs) {
        const int row = (int)(i >> 10), c = (int)(i & 1023);
        int path, b, t; if (row < MP) { path = 0; b = row >> 12; t = row & 4095; } else { path = 1; b = (row - MP) >> 3; t = (row - MP) & 7; }
        const float* u = P.U + (size_t)row * PROJ;
        const float z0 = u[C_CG + c] * u[C_XIN + c];
        float z1, z2;
        if (t >= 1) z1 = (u - PROJ)[C_CG + c] * (u - PROJ)[C_XIN + c]; else z1 = path ? P.state_conv[((size_t)b * 2 + 1) * 1024 + c] : 0.f;
        if (t >= 2) z2 = (u - 2 * PROJ)[C_CG + c] * (u - 2 * PROJ)[C_XIN + c]; else z2 = path ? P.state_conv[((size_t)b * 2 + (t == 1 ? 1 : 0)) * 1024 + c] : 0.f;
        const float y = P.conv_w[2 * 1024 + c] * z0 + P.conv_w[0 * 1024 + c] * z2 + P.conv_w[1 * 1024 + c] * z1;
        P.A2[(size_t)row * 2048 + 1024 + c] = u[C_BG + c] * y;
        if (!path && t >= SEQ - 2) P.out[O5 + (((size_t)l * 2 + b) * 2 + (t - (SEQ - 2))) * 1024 + c] = z0;
        if (path && t >= 6) P.out[O9 + (((size_t)l * 8 + b) * 2 + (t - 6)) * 1024 + c] = z0;
    }
}

template <int NT>
__device__ __forceinline__ void softmax_rows(float* S, int n, int wid, int lane) {
    if (wid < 4) {
        float* s = S + wid * 1024;
        float m = -1e30f;
        for (int i = lane; i < n; i += 64) m = fmaxf(m, s[i]);
        m = wave_max(m);
        float sum = 0.f;
        for (int i = lane; i < n; i += 64) { const float v = s[i]; const float e = (v > -1e29f) ? __expf(v - m) : 0.f; s[i] = e; sum += e; }
        sum = wave_sum(sum);
        const float inv = 1.0f / fmaxf(sum, 1e-30f);
        for (int i = lane; i < n; i += 64) s[i] *= inv;
    }
}

template <int NT>
__device__ __forceinline__ void attn_task(const LayerP& P, int path, int b, int g, int t, float* sm) {
    const int tid = threadIdx.x, lane = tid & 63, wid = tid >> 6;
    const int past = path ? 16384 : 0;
    const int row = path ? (MP + b * 8 + t) : (b * SEQ + t);
    const int pos = past + t, cur = pos >> 6;
    const int n_blk = path ? NBLK_S : NBLK_P;
    float* q = sm;
    float* S = sm + 256;
    volatile float* score = S + 4096;
    volatile int* sel = (volatile int*)(S + 4096 + 272);
    const float* u = P.U + (size_t)row * PROJ;
    __syncthreads();
    if (tid < 256) q[tid] = u[C_Q + g * 256 + tid];
    __syncthreads();
    const float* kc = path ? P.kcmp_s + (size_t)b * NBLK_S * 512 : P.kcmp_p + (size_t)b * NBLK_P * 512;
    for (int idx = tid; idx < 4 * n_blk; idx += NT) {
        const int r = idx / n_blk, n = idx - r * n_blk;
        float s = -1e30f;
        if (n * 64 + 63 <= pos) { const float* k = kc + (size_t)n * 512 + g * 64; const float* qq = q + r * 64; float a = 0.f;
            for (int d = 0; d < 64; ++d) a = fmaf(qq[d], k[d], a);
            s = a * 0.125f; }
        S[r * 1024 + n] = s;
    }
    __syncthreads();
    softmax_rows<NT>(S, n_blk, wid, lane);
    __syncthreads();
    for (int n = tid; n < n_blk; n += NT) {
        const float imp = (S[n] + S[1024 + n]) + (S[2048 + n] + S[3072 + n]);
        const bool forced = (n == 0) || (n == cur) || (n == cur - 1);
        score[n] = forced ? 1e9f : (n <= cur ? imp : -1e9f);
    }
    float o_cmp = 0.f;
    const int r_ = (tid >> 6) & 3, d_ = tid & 63;
    if (tid < 256) { for (int n = 0; n < n_blk; ++n) { const float p = S[r_ * 1024 + n]; if (p != 0.f) o_cmp = fmaf(p, kc[(size_t)n * 512 + 256 + g * 64 + d_], o_cmp); } }
    __syncthreads();
    if (wid == 0) {
        for (int j = 0; j < 16; ++j) {
            float best = -3.0e38f; int bi = 0x7fffffff;
            for (int n = lane; n < n_blk; n += 64) { const float v = score[n]; if (v > best) { best = v; bi = n; } }
#pragma unroll
            for (int o = 1; o < 64; o <<= 1) { const float ov = __shfl_xor(best, o); const int oi = __shfl_xor(bi, o); if (ov > best || (ov == best && oi < bi)) { best = ov; bi = oi; } }
            if (lane == 0) { sel[j] = bi; score[bi] = -3.4e38f; }
            __builtin_amdgcn_fence(__ATOMIC_RELEASE, "wavefront"); __builtin_amdgcn_wave_barrier(); __builtin_amdgcn_fence(__ATOMIC_ACQUIRE, "wavefront");
        }
    }
    __syncthreads();
    for (int kidx = tid; kidx < 1024; kidx += NT) {
        const int kpos = sel[kidx >> 6] * 64 + (kidx & 63);
        float s0 = -1e30f, s1 = -1e30f, s2 = -1e30f, s3 = -1e30f;
        if (kpos <= pos) { const float* k = slc_row(P, path, b, kpos) + g * 64; float a0 = 0.f, a1 = 0.f, a2 = 0.f, a3 = 0.f;
            for (int d = 0; d < 64; ++d) { const float kv = k[d]; a0 = fmaf(q[d], kv, a0); a1 = fmaf(q[64 + d], kv, a1); a2 = fmaf(q[128 + d], kv, a2); a3 = fmaf(q[192 + d], kv, a3); }
            s0 = a0 * 0.125f; s1 = a1 * 0.125f; s2 = a2 * 0.125f; s3 = a3 * 0.125f; }
        S[kidx] = s0; S[1024 + kidx] = s1; S[2048 + kidx] = s2; S[3072 + kidx] = s3;
    }
    __syncthreads();
    softmax_rows<NT>(S, 1024, wid, lane);
    __syncthreads();
    float o_sel = 0.f;
    if (tid < 256) { for (int kidx = 0; kidx < 1024; ++kidx) { const float p = S[r_ * 1024 + kidx]; if (p != 0.f) { const int kpos = sel[kidx >> 6] * 64 + (kidx & 63); o_sel = fmaf(p, slc_row(P, path, b, kpos)[256 + g * 64 + d_], o_sel); } } }
    __syncthreads();
    const int wp0 = path ? 15872 : 0;
    for (int i = tid; i < 512; i += NT) {
        const int kpos = pos - 511 + i;
        float s0 = -1e30f, s1 = -1e30f, s2 = -1e30f, s3 = -1e30f;
        if (kpos >= wp0) { const float* k = win_row(P, path, b, kpos) + g * 64; float a0 = 0.f, a1 = 0.f, a2 = 0.f, a3 = 0.f;
            for (int d = 0; d < 64; ++d) { const float kv = k[d]; a0 = fmaf(q[d], kv, a0); a1 = fmaf(q[64 + d], kv, a1); a2 = fmaf(q[128 + d], kv, a2); a3 = fmaf(q[192 + d], kv, a3); }
            s0 = a0 * 0.125f; s1 = a1 * 0.125f; s2 = a2 * 0.125f; s3 = a3 * 0.125f; }
        S[i] = s0; S[1024 + i] = s1; S[2048 + i] = s2; S[3072 + i] = s3;
    }
    __syncthreads();
    softmax_rows<NT>(S, 512, wid, lane);
    __syncthreads();
    if (tid < 256) {
        float o_win = 0.f;
        for (int i = 0; i < 512; ++i) { const float p = S[r_ * 1024 + i]; if (p != 0.f) o_win = fmaf(p, win_row(P, path, b, pos - 511 + i)[256 + g * 64 + d_], o_win); }
        const float* gp = u + C_G + g * 12 + r_ * 3;
        const float g0 = 1.f / (1.f + __expf(-gp[0])), g1 = 1.f / (1.f + __expf(-gp[1])), g2 = 1.f / (1.f + __expf(-gp[2]));
        P.A2[(size_t)row * 2048 + g * 256 + r_ * 64 + d_] = g0 * o_cmp + g1 * o_sel + g2 * o_win;
    }
}

__global__ __launch_bounds__(256) void attn_kernel(LayerP P) {
    __shared__ float sm[256 + 4096 + 272 + 16];
    const int task = blockIdx.x;
    int path, b, t, g;
    if (task < MP * 4) { path = 0; g = task & 3; const int row = task >> 2; b = row >> 12; t = row & 4095; }
    else { path = 1; const int k = task - MP * 4; g = k & 3; const int row = k >> 2; b = row >> 3; t = row & 7; }
    attn_task<256>(P, path, b, g, t, sm);
}

__global__ __launch_bounds__(256) void ln_kernel(const float* __restrict__ X, const float* __restrict__ R, const float* __restrict__ gam, const float* __restrict__ bet, float* __restrict__ Y, int rows) {
    const int lane = threadIdx.x & 63, w = blockIdx.x * 4 + (threadIdx.x >> 6);
    if (w >= rows) return;
    const float4* x = (const float4*)(X + (size_t)w * D_MODEL); const float4* r = (const float4*)(R + (size_t)w * D_MODEL);
    float4 v[8]; float s = 0.f;
#pragma unroll
    for (int j = 0; j < 8; ++j) { const float4 a = x[lane + 64 * j], c = r[lane + 64 * j]; v[j] = make_float4(ALPHA * a.x + c.x, ALPHA * a.y + c.y, ALPHA * a.z + c.z, ALPHA * a.w + c.w); s += (v[j].x + v[j].y) + (v[j].z + v[j].w); }
    const float mean = wave_sum(s) * (1.f / D_MODEL); float s2 = 0.f;
#pragma unroll
    for (int j = 0; j < 8; ++j) { v[j].x -= mean; v[j].y -= mean; v[j].z -= mean; v[j].w -= mean; s2 += (v[j].x * v[j].x + v[j].y * v[j].y) + (v[j].z * v[j].z + v[j].w * v[j].w); }
    const float rstd = rsqrtf(wave_sum(s2) * (1.f / D_MODEL) + LN_EPS);
    float4* y = (float4*)(Y + (size_t)w * D_MODEL);
#pragma unroll
    for (int j = 0; j < 8; ++j) { const float4 gg = ((const float4*)gam)[lane + 64 * j], bb = ((const float4*)bet)[lane + 64 * j];
        y[lane + 64 * j] = make_float4(v[j].x * rstd * gg.x + bb.x, v[j].y * rstd * gg.y + bb.y, v[j].z * rstd * gg.z + bb.z, v[j].w * rstd * gg.w + bb.w); }
}
}

extern "C" void kernel_launch(void* const* d_in, const int* in_sizes, int n_in, void* d_out, int out_size, void* d_ws, size_t ws_size, hipStream_t stream) {
    (void)in_sizes; (void)n_in; (void)out_size; (void)ws_size;
    const float* x_prompt = (const float*)d_in[0]; const float* x_sample = (const float*)d_in[1];
    const float* cache_cmp = (const float*)d_in[2]; const float* cache_slc = (const float*)d_in[3]; const float* cache_win = (const float*)d_in[4];
    const float* state_conv = (const float*)d_in[5]; const int* page_table = (const int*)d_in[6];
    const float* w_in = (const float*)d_in[7]; const float* w_cmp_k = (const float*)d_in[8]; const float* w_cmp_v = (const float*)d_in[9];
    const float* conv_w = (const float*)d_in[10]; const float* w_out = (const float*)d_in[11];
    const float* ln1_g = (const float*)d_in[12]; const float* ln1_b = (const float*)d_in[13];
    const float* w1 = (const float*)d_in[14]; const float* w2 = (const float*)d_in[15];
    const float* ln2_g = (const float*)d_in[16]; const float* ln2_b = (const float*)d_in[17];
    float* out = (float*)d_out;
    float* ws = (float*)d_ws;
    size_t off = 0;
    auto take = [&](size_t n) { float* p = ws + off; off += (n + 63) & ~(size_t)63; return p; };
    float* XB = take((size_t)M * D_MODEL);
    float* U = take((size_t)M * PROJ);
    float* A2 = take((size_t)M * D_MODEL);
    float* MIX = take((size_t)M * D_MODEL);
    float* H = take((size_t)M * D_MODEL);
    float* ACT = take((size_t)M * D_FF);
    float* F = take((size_t)M * D_MODEL);
    float* Y0 = take((size_t)M * D_MODEL);
    float* KCP = take((size_t)2 * NBLK_P * 512);
    float* KCS = take((size_t)8 * NBLK_S * 512);
    hipMemcpyAsync(XB, x_prompt, (size_t)MP * D_MODEL * 4, hipMemcpyDeviceToDevice, stream);
    hipMemcpyAsync(XB + (size_t)MP * D_MODEL, x_sample, (size_t)MS * D_MODEL * 4, hipMemcpyDeviceToDevice, stream);
    for (int l = 0; l < DEPTH; ++l) {
        const float* Xl = l == 0 ? XB : Y0;
        float* Yl = l == DEPTH - 1 ? out : Y0;
        gemm_f32<0><<<dim3((PROJ + 127) / 128, (M + 127) / 128), 256, 0, stream>>>(Xl, D_MODEL, w_in + (size_t)l * D_MODEL * PROJ, PROJ, U, PROJ, M, PROJ, D_MODEL);
        LayerP P{};
        P.U = U; P.cache_cmp = cache_cmp + (size_t)l * 1280 * 128 * 512; P.cache_slc = cache_slc + (size_t)l * 1280 * 128 * 512; P.cache_win = cache_win + (size_t)l * 8 * 512 * 512;
        P.state_conv = state_conv + (size_t)l * 8 * 2 * 1024; P.page_table = page_table; P.w_cmp_k = w_cmp_k + (size_t)l * 4096; P.w_cmp_v = w_cmp_v + (size_t)l * 4096;
        P.conv_w = conv_w + (size_t)l * 3 * 1024; P.kcmp_p = KCP; P.kcmp_s = KCS; P.A2 = A2; P.out = out; P.layer = l; P.pad = 0;
        scatter_kernel<<<2048, 256, 0, stream>>>(P);
        cmp_kernel<<<2 * NBLK_P + 8 * NBLK_S, 512, 0, stream>>>(P);
        conv_kernel<<<2048, 256, 0, stream>>>(P);
        attn_kernel<<<M * 4, 256, 0, stream>>>(P);
        gemm_f32<0><<<dim3(D_MODEL / 128, (M + 127) / 128), 256, 0, stream>>>(A2, D_MODEL, w_out + (size_t)l * D_MODEL * D_MODEL, D_MODEL, MIX, D_MODEL, M, D_MODEL, D_MODEL);
        ln_kernel<<<(M + 3) / 4, 256, 0, stream>>>(Xl, MIX, ln1_g + (size_t)l * D_MODEL, ln1_b + (size_t)l * D_MODEL, H, M);
        gemm_f32<1><<<dim3(D_FF / 128, (M + 127) / 128), 256, 0, stream>>>(H, D_MODEL, w1 + (size_t)l * D_MODEL * D_FF, D_FF, ACT, D_FF, M, D_FF, D_MODEL);
        gemm_f32<0><<<dim3(D_MODEL / 128, (M + 127) / 128), 256, 0, stream>>>(ACT, D_FF, w2 + (size_t)l * D_FF * D_MODEL, D_MODEL, F, D_MODEL, M, D_MODEL, D_FF);
        ln_kernel<<<(M + 3) / 4, 256, 0, stream>>>(H, F, ln2_g + (size_t)l * D_MODEL, ln2_b + (size_t)l * D_MODEL, Yl, M);
    }
}
```

```cpp
#include <hip/hip_runtime.h>
#include <cstdio>
#include <cstdint>
namespace pg8 {
#define PG8_LAS __attribute__((address_space(3)))
typedef unsigned short bf16_t;
typedef short bf16x8 __attribute__((ext_vector_type(8)));
typedef float f32x4 __attribute__((ext_vector_type(4)));
typedef unsigned u32x4 __attribute__((ext_vector_type(4)));
constexpr int BM = 256, BK = 64, HALF = 128, HTB = HALF * BK * 2  , STAGE_BYTES = 8 * HTB, NXCD = 8, WGM = 8;

__host__ __device__ __forceinline__ int lds_byte(int r, int c) { const int st = (r >> 4) * 2 + (c >> 5), rr = r & 15, cc = c & 31, ob = rr * 64 + cc * 2; return st * 1024 + (ob ^ (((ob >> 9) & 1) << 5)); }
__host__ __device__ __forceinline__ void stage_rc(int b, int& R, int& C) { const int st = b / 1024, sb = b % 1024, swz = sb ^ (((sb >> 9) & 1) << 5); R = (st >> 1) * 16 + swz / 64; C = (st & 1) * 32 + (swz % 64) / 2; }
__host__ __device__ __forceinline__ int perm32(int rho) { const int n = rho >> 4, i = rho & 15; return 8 * (i >> 2) + 4 * n + (i & 3); }

struct Unit { int pm, pn; };
struct Gemm { const bf16_t* A; const bf16_t* Bt; int M, N, K; };

struct StaticOrder {
    int nM, nN, nwg, G, c;
    __host__ __device__ void init(int M, int N, int G_, int c_) { nM = M / BM; nN = N / BM; nwg = nM * nN; G = G_; c = c_; }
    __host__ __device__ bool next(int i, Unit& u) const {
        const long L = (long)i * G + c; if (L >= nwg) return false;
        int wgid = (int)L; { const int q = nwg / NXCD, r = nwg % NXCD, xcd = wgid % NXCD, off = wgid / NXCD; wgid = (xcd < r ? xcd * (q + 1) : r * (q + 1) + (xcd - r) * q) + off; }
        const int nig = WGM * nN, gid = wgid / nig, fm = gid * WGM, gsz = (nM - fm) < WGM ? (nM - fm) : WGM;
        u.pm = fm + ((wgid % nig) % gsz); u.pn = (wgid % nig) / gsz; return true;
    }
    __device__ __forceinline__ void a_ready(const Unit&) const {}
    __device__ __forceinline__ void done(const Unit&) const {}
};

__device__ __forceinline__ unsigned cvt_pk_bf16(float lo, float hi) { unsigned r; asm volatile("v_cvt_pk_bf16_f32 %0, %1, %2" : "=v"(r) : "v"(lo), "v"(hi)); return r; }
__device__ __forceinline__ u32x4 pack8(const f32x4 v0, const f32x4 v1) { u32x4 w; w.x = cvt_pk_bf16(v0[0], v0[1]); w.y = cvt_pk_bf16(v0[2], v0[3]); w.z = cvt_pk_bf16(v1[0], v1[1]); w.w = cvt_pk_bf16(v1[2], v1[3]); return w; }

constexpr int EP_MROWS = 8256, EP_MP = 8192;
constexpr float EP_C2 = 0.125f * 1.4426950408889634f;
constexpr size_t EO2 = 16908288, EO3 = 25296896, EO4 = 33685504, EO5 = 34734080, EO6 = 34742272, EO7 = 34807808, EO8 = 34873344, EO9 = 39067648;

struct EpiInProj {
    static constexpr bool PERM = true, AFTER_DRAIN = false;
    bf16_t* Q; bf16_t* KV;   bf16_t* Z; bf16_t* BG; float* G; float* out; int layer;
    __device__ __forceinline__ void operator()(const f32x4 (&acc)[2][2][4][2], const Unit& u, int wr, int wc, int fr, int fq) const {
        const int pn = u.pn;
        const int row0 = u.pm * BM + wr * 64 + fr;
        if (pn < 4) {
#pragma unroll
            for (int ai = 0; ai < 2; ++ai)
#pragma unroll
                for (int m = 0; m < 4; ++m) { const int row = row0 + ai * HALF + m * 16; if (row < EP_MROWS) {
                    bf16_t* dst = Q + (size_t)row * 1024 + pn * 256 + wc * 32 + 8 * fq;
#pragma unroll
                    for (int bj = 0; bj < 2; ++bj) *(u32x4*)(dst + bj * HALF) = pack8(acc[ai][bj][m][0] * EP_C2, acc[ai][bj][m][1] * EP_C2); } }
        } else if (pn < 10) {
            const int which = (pn - 4) >> 1, cbase = ((pn - 4) & 1) * 256 + wc * 32 + 8 * fq;
            bf16_t* kvb = KV + (size_t)which * ((size_t)8448 * 512);
#pragma unroll
            for (int ai = 0; ai < 2; ++ai)
#pragma unroll
                for (int m = 0; m < 4; ++m) { const int row = row0 + ai * HALF + m * 16; if (row < EP_MROWS) {
                    float* fo = nullptr;
                    if (row < EP_MP) { const int b = row >> 12, t = row & 4095;
                        if (which == 0) fo = out + EO2 + ((size_t)layer * EP_MP + row) * 512;
                        else if (which == 1) fo = out + EO3 + ((size_t)layer * EP_MP + row) * 512;
                        else if (t >= 3584) fo = out + EO4 + (((size_t)layer * 2 + b) * 512 + (t - 3584)) * 512;
                    } else { const int s = row - EP_MP, b = s >> 3, t = s & 7;
                        if (which == 0) fo = out + EO6 + ((size_t)layer * 64 + s) * 512;
                        else if (which == 1) fo = out + EO7 + ((size_t)layer * 64 + s) * 512;
                        else fo = out + EO8 + (((size_t)layer * 8 + b) * 512 + 504 + t) * 512; }
#pragma unroll
                    for (int bj = 0; bj < 2; ++bj) { const int c = cbase + bj * HALF;
                        *(u32x4*)(kvb + (size_t)row * 512 + c) = pack8(acc[ai][bj][m][0], acc[ai][bj][m][1]);
                        if (fo) { *(f32x4*)(fo + c) = acc[ai][bj][m][0]; *(f32x4*)(fo + c + 4) = acc[ai][bj][m][1]; } } } }
        } else if (pn < 18) {
            const int c = (pn - 10) * 128 + wc * 32 + 8 * fq;
#pragma unroll
            for (int ai = 0; ai < 2; ++ai)
#pragma unroll
                for (int m = 0; m < 4; ++m) { const int row = row0 + ai * HALF + m * 16; if (row < EP_MROWS) {
                    const f32x4 z0 = acc[ai][0][m][0] * acc[ai][1][m][0], z1 = acc[ai][0][m][1] * acc[ai][1][m][1];
                    *(u32x4*)(Z + (size_t)row * 1024 + c) = pack8(z0, z1);
                    float* so = nullptr;
                    if (row < EP_MP) { const int b = row >> 12, t = row & 4095; if (t >= 4094) so = out + EO5 + (((size_t)layer * 2 + b) * 2 + (t - 4094)) * 1024 + c; }
                    else { const int s = row - EP_MP, b = s >> 3, t = s & 7; if (t >= 6) so = out + EO9 + (((size_t)layer * 8 + b) * 2 + (t - 6)) * 1024 + c; }
                    if (so) { *(f32x4*)so = z0; *(f32x4*)(so + 4) = z1; } } }
        } else if (pn < 22) {
#pragma unroll
            for (int ai = 0; ai < 2; ++ai)
#pragma unroll
                for (int m = 0; m < 4; ++m) { const int row = row0 + ai * HALF + m * 16; if (row < EP_MROWS) {
                    bf16_t* dst = BG + (size_t)row * 1024 + (pn - 18) * 256 + wc * 32 + 8 * fq;
#pragma unroll
                    for (int bj = 0; bj < 2; ++bj) *(u32x4*)(dst + bj * HALF) = pack8(acc[ai][bj][m][0], acc[ai][bj][m][1]); } }
        } else {
            if (wc == 0 || (wc == 1 && fq < 2)) {
#pragma unroll
                for (int ai = 0; ai < 2; ++ai)
#pragma unroll
                    for (int m = 0; m < 4; ++m) { const int row = row0 + ai * HALF + m * 16; if (row < EP_MROWS) {
                        float* dst = G + (size_t)row * 48 + wc * 32 + 8 * fq;
#pragma unroll
                        for (int n = 0; n < 2; ++n) { const f32x4 v = acc[ai][0][m][n]; f32x4 s;
#pragma unroll
                            for (int e = 0; e < 4; ++e) s[e] = 1.0f / (1.0f + __expf(-v[e]));
                            *(f32x4*)(dst + 4 * n) = s; } } }
            }
        }
    }
};

struct EpiF32 {
    static constexpr bool PERM = false, AFTER_DRAIN = false;
    float* C; int ldc;
    __device__ __forceinline__ void operator()(const f32x4 (&acc)[2][2][4][2], const Unit& u, int wr, int wc, int fr, int fq) const {
        const int row0 = u.pm * BM + wr * 64 + fr, col0 = u.pn * BM + wc * 32 + 4 * fq;
#pragma unroll
        for (int ai = 0; ai < 2; ++ai)
#pragma unroll
            for (int m = 0; m < 4; ++m) { float* rowp = C + (size_t)(row0 + ai * HALF + m * 16) * ldc + col0;
#pragma unroll
                for (int bj = 0; bj < 2; ++bj)
#pragma unroll
                    for (int n = 0; n < 2; ++n) *(f32x4*)(rowp + bj * HALF + n * 16) = acc[ai][bj][m][n]; }
    }
};

struct EpiRelu2 {
    static constexpr bool PERM = true, AFTER_DRAIN = false;
    bf16_t* O; int ldc;
    __device__ __forceinline__ void operator()(const f32x4 (&acc)[2][2][4][2], const Unit& u, int wr, int wc, int fr, int fq) const {
        const int row0 = u.pm * BM + wr * 64 + fr, col0 = u.pn * BM + wc * 32 + 8 * fq;
#pragma unroll
        for (int ai = 0; ai < 2; ++ai)
#pragma unroll
            for (int m = 0; m < 4; ++m) { bf16_t* rowp = O + (size_t)(row0 + ai * HALF + m * 16) * ldc + col0;
#pragma unroll
                for (int bj = 0; bj < 2; ++bj) { f32x4 v0 = acc[ai][bj][m][0], v1 = acc[ai][bj][m][1];
#pragma unroll
                    for (int e = 0; e < 4; ++e) { const float a = fmaxf(v0[e], 0.f), b = fmaxf(v1[e], 0.f); v0[e] = a * a; v1[e] = b * b; }
                    *(u32x4*)(rowp + bj * HALF) = pack8(v0, v1); } }
    }
};

template <class Epi, class Sched, bool ALIGN_EPI = false, bool SP2 = false>
__device__ __forceinline__ void gemm_phase(PG8_LAS unsigned char* lds, const Gemm g, const Sched& S, const Epi& E) {
    int tid_o = threadIdx.x; asm volatile("" : "+v"(tid_o));
    const int tid = tid_o, wid = __builtin_amdgcn_readfirstlane(tid >> 6), lane = tid & 63, wr = wid >> 2, wc = wid & 3, fr = lane & 15, fq = lane >> 4;
    const int K = g.K, nt = K / BK;
    unsigned voffA[2], voffB[2];
#pragma unroll
    for (int i = 0; i < 2; ++i) { int R, C; stage_rc(tid * 16 + i * 8192, R, C); const int Rb = Epi::PERM ? ((R & ~31) + perm32(R & 31)) : R;
        voffA[i] = (unsigned)(R * K + C) * 2u; voffB[i] = (unsigned)(Rb * K + C) * 2u; }
    const size_t kstep = (size_t)(BK * 2);
    const size_t hstep = (size_t)HALF * K * 2;
    const size_t tstep = 2 * hstep;
    const unsigned ldsw = (unsigned)wid * 1024u;
    const int aoff = lds_byte(wr * 64 + fr, fq * 8), boff = lds_byte(wc * 32 + fr, fq * 8);
#define PG8_SA(b, h) (((b) * 2 + (h)) * HTB)
#define PG8_SB(b, h) ((4 + (b) * 2 + (h)) * HTB)
#define PG8_STAGE(bufoff, gbase, voff) do { _Pragma("unroll") for (int _i = 0; _i < 2; ++_i) \
        __builtin_amdgcn_global_load_lds((const unsigned*)((const char*)(gbase) + (voff)[_i]), (PG8_LAS unsigned*)(lds + (bufoff) + ldsw + _i * 8192), 16, 0, 0); } while (0)
#define PG8_LDA(dst, b, h) do { _Pragma("unroll") for (int m = 0; m < 4; ++m) _Pragma("unroll") for (int k = 0; k < 2; ++k) dst[m][k] = *(const PG8_LAS bf16x8*)(lds + PG8_SA(b, h) + aoff + m * 2048 + k * 1024); } while (0)
#define PG8_LDB(dst, b, h) do { _Pragma("unroll") for (int n = 0; n < 2; ++n) _Pragma("unroll") for (int k = 0; k < 2; ++k) dst[n][k] = *(const PG8_LAS bf16x8*)(lds + PG8_SB(b, h) + boff + n * 2048 + k * 1024); } while (0)
#define PG8_MMA(ai, bj, At, Bt) do { __builtin_amdgcn_s_setprio(1); _Pragma("unroll") for (int m = 0; m < 4; ++m) _Pragma("unroll") for (int n = 0; n < 2; ++n) _Pragma("unroll") for (int k = 0; k < 2; ++k) \
        acc[ai][bj][m][n] = __builtin_amdgcn_mfma_f32_16x16x32_bf16(Bt[n][k], At[m][k], acc[ai][bj][m][n], 0, 0, 0); __builtin_amdgcn_s_setprio(0); } while (0)
#define PG8_WAIT_V(n) asm volatile("s_waitcnt vmcnt(" #n ")" ::: "memory")
#define PG8_WAIT_L(n) asm volatile("s_waitcnt lgkmcnt(" #n ")" ::: "memory")
#define PG8_BAR __builtin_amdgcn_s_barrier()
#define PG8_SCHED __builtin_amdgcn_sched_barrier(0)
    Unit cur, nxt; int ui = 0;
    if (!S.next(0, cur)) return;
    f32x4 acc[2][2][4][2];
#pragma unroll
    for (int a = 0; a < 2; ++a)
#pragma unroll
        for (int b = 0; b < 2; ++b)
#pragma unroll
            for (int m = 0; m < 4; ++m)
#pragma unroll
                for (int n = 0; n < 2; ++n) acc[a][b][m][n] = (f32x4){0.f, 0.f, 0.f, 0.f};
    bf16x8 At[4][2], B0[2][2], B1[2][2];
    const char* cA = (const char*)g.A + (size_t)cur.pm * tstep; const char* cB = (const char*)g.Bt + (size_t)cur.pn * tstep;
    S.a_ready(cur);
    if constexpr (SP2) {
        PG8_STAGE(PG8_SB(0, 0), cB, voffB); PG8_STAGE(PG8_SB(0, 1), cB + hstep, voffB); PG8_STAGE(PG8_SA(0, 0), cA, voffA); PG8_STAGE(PG8_SA(0, 1), cA + hstep, voffA);
        if (wr == 1) PG8_BAR;
        PG8_WAIT_V(2); PG8_BAR;
        PG8_STAGE(PG8_SB(1, 0), cB + kstep, voffB); PG8_STAGE(PG8_SA(1, 0), cA + kstep, voffA); PG8_STAGE(PG8_SB(1, 1), cB + hstep + kstep, voffB);
        PG8_WAIT_V(6); PG8_BAR;
    } else {
        PG8_STAGE(PG8_SB(0, 0), cB, voffB); PG8_STAGE(PG8_SA(0, 0), cA, voffA); PG8_STAGE(PG8_SB(0, 1), cB + hstep, voffB); PG8_STAGE(PG8_SA(0, 1), cA + hstep, voffA);
        if (wr == 1) PG8_BAR;
        PG8_WAIT_V(4); PG8_BAR;
        PG8_STAGE(PG8_SB(1, 0), cB + kstep, voffB); PG8_STAGE(PG8_SA(1, 0), cA + kstep, voffA); PG8_STAGE(PG8_SB(1, 1), cB + hstep + kstep, voffB);
        PG8_WAIT_V(6); PG8_BAR;
    }
    for (;;) {
        const bool has_next = S.next(ui + 1, nxt);
        const char* nA = has_next ? (const char*)g.A + (size_t)nxt.pm * tstep : cA; const char* nB = has_next ? (const char*)g.Bt + (size_t)nxt.pn * tstep : cB;
        for (int t = 0; t < nt; t += 2) {
            const bool last = (t == nt - 2);
            const char* a1 = cA + (size_t)(t + 1) * kstep;
            const char* a2 = last ? nA : cA + (size_t)(t + 2) * kstep; const char* b2 = last ? nB : cB + (size_t)(t + 2) * kstep;
            const char* a3 = a2 + kstep; const char* b3 = b2 + kstep;
            if (last && has_next) S.a_ready(nxt);
            if constexpr (SP2) {
            PG8_LDB(B0, 0, 0); PG8_LDB(B1, 0, 1); PG8_SCHED; PG8_LDA(At, 0, 0); PG8_STAGE(PG8_SA(1, 1), a1 + hstep, voffA);
            PG8_WAIT_V(8); PG8_WAIT_L(0); PG8_BAR; PG8_MMA(0, 0, At, B0); PG8_MMA(0, 1, At, B1); PG8_BAR; PG8_SCHED;
            PG8_LDA(At, 0, 1); PG8_STAGE(PG8_SB(0, 0), b2, voffB); PG8_STAGE(PG8_SB(0, 1), b2 + hstep, voffB); PG8_STAGE(PG8_SA(0, 0), a2, voffA);
            PG8_WAIT_V(8); PG8_WAIT_L(0); PG8_BAR; PG8_MMA(1, 0, At, B0); PG8_MMA(1, 1, At, B1); PG8_BAR; PG8_SCHED;
            PG8_LDB(B0, 1, 0); PG8_LDB(B1, 1, 1); PG8_SCHED; PG8_LDA(At, 1, 0); PG8_STAGE(PG8_SA(0, 1), a2 + hstep, voffA);
            PG8_WAIT_V(8); PG8_WAIT_L(0); PG8_BAR; PG8_MMA(0, 0, At, B0); PG8_MMA(0, 1, At, B1); PG8_BAR; PG8_SCHED;
            PG8_LDA(At, 1, 1); PG8_STAGE(PG8_SB(1, 0), b3, voffB); PG8_STAGE(PG8_SB(1, 1), b3 + hstep, voffB); PG8_STAGE(PG8_SA(1, 0), a3, voffA);
            PG8_WAIT_V(8); PG8_WAIT_L(0); PG8_BAR; PG8_MMA(1, 0, At, B0); PG8_MMA(1, 1, At, B1); PG8_BAR; PG8_SCHED;
            } else {
            PG8_LDB(B0, 0, 0); PG8_SCHED; PG8_LDA(At, 0, 0); PG8_STAGE(PG8_SA(1, 1), a1 + hstep, voffA);
            PG8_WAIT_L(8); PG8_BAR; PG8_WAIT_L(0); PG8_MMA(0, 0, At, B0); PG8_BAR; PG8_SCHED;
            PG8_LDB(B1, 0, 1); PG8_STAGE(PG8_SB(0, 0), b2, voffB);
            PG8_BAR; PG8_WAIT_L(0); PG8_MMA(0, 1, At, B1); PG8_BAR;
            PG8_LDA(At, 0, 1); PG8_STAGE(PG8_SA(0, 0), a2, voffA);
            PG8_BAR; PG8_WAIT_L(0); PG8_MMA(1, 0, At, B0); PG8_BAR; PG8_SCHED;
            PG8_STAGE(PG8_SB(0, 1), b2 + hstep, voffB);
            PG8_WAIT_V(6); PG8_BAR; PG8_MMA(1, 1, At, B1); PG8_BAR;
            PG8_LDB(B0, 1, 0); PG8_SCHED; PG8_LDA(At, 1, 0); PG8_STAGE(PG8_SA(0, 1), a2 + hstep, voffA);
            PG8_WAIT_L(8); PG8_BAR; PG8_WAIT_L(0); PG8_MMA(0, 0, At, B0); PG8_BAR; PG8_SCHED;
            PG8_LDB(B1, 1, 1); PG8_STAGE(PG8_SB(1, 0), b3, voffB);
            PG8_BAR; PG8_WAIT_L(0); PG8_MMA(0, 1, At, B1); PG8_BAR;
            PG8_LDA(At, 1, 1); PG8_STAGE(PG8_SA(1, 0), a3, voffA);
            PG8_BAR; PG8_WAIT_L(0); PG8_MMA(1, 0, At, B0); PG8_BAR; PG8_SCHED;
            PG8_STAGE(PG8_SB(1, 1), b3 + hstep, voffB);
            PG8_WAIT_V(6); PG8_BAR; PG8_MMA(1, 1, At, B1); PG8_BAR;
            }
        }
        if constexpr (ALIGN_EPI) { if (wr == 0) PG8_BAR; }
        if constexpr (!Epi::AFTER_DRAIN) { E(acc, cur, wr, wc, fr, fq); S.done(cur); }
        if (!has_next) break;
#pragma unroll
        for (int a = 0; a < 2; ++a)
#pragma unroll
            for (int b = 0; b < 2; ++b)
#pragma unroll
                for (int m = 0; m < 4; ++m)
#pragma unroll
                    for (int n = 0; n < 2; ++n) acc[a][b][m][n] = (f32x4){0.f, 0.f, 0.f, 0.f};
        cur = nxt; cA = nA; cB = nB; ++ui;
        if constexpr (ALIGN_EPI) { if (wr == 1) PG8_BAR; }
    }
    PG8_WAIT_V(0);
    if constexpr (!ALIGN_EPI) { if (wr == 0) PG8_BAR; }
    PG8_BAR;
    if constexpr (Epi::AFTER_DRAIN) { E.fused(acc, cur, wr, wc, fr, fq, lds, wid, lane); S.done(cur); }
#undef PG8_SA
#undef PG8_SB
#undef PG8_STAGE
#undef PG8_LDA
#undef PG8_LDB
#undef PG8_MMA
#undef PG8_WAIT_V
#undef PG8_WAIT_L
#undef PG8_BAR
#undef PG8_SCHED
}
}
#define GAS __attribute__((address_space(1)))
#define LAS __attribute__((address_space(3)))
typedef unsigned short bf16;
typedef unsigned v4u __attribute__((ext_vector_type(4)));
typedef float f32x4 __attribute__((ext_vector_type(4)));
typedef short bf16x8 __attribute__((ext_vector_type(8)));
typedef GAS unsigned gu32;
typedef GAS unsigned long long gu64;
#define RLX_AGENT __ATOMIC_RELAXED, __HIP_MEMORY_SCOPE_AGENT
#define LDS_WAIT() asm volatile("s_waitcnt lgkmcnt(0)" ::: "memory")
#define VM_WAIT() asm volatile("s_waitcnt vmcnt(0)" ::: "memory")
__device__ __forceinline__ unsigned long long rt() { return __builtin_amdgcn_s_memrealtime(); }
__device__ __forceinline__ unsigned f2bf(float f) { unsigned u = __builtin_bit_cast(unsigned, f); return (u + 0x7fffu + ((u >> 16) & 1u)) >> 16; }
__device__ __forceinline__ unsigned pk2(float lo, float hi) { return f2bf(lo) | (f2bf(hi) << 16); }

#define XB_TMO      128
#define XB_XCNT(j)  (256  + 64 * (j))
#define XB_XSUB(j)  (1280 + 64 * (j))
#define XB_XGEN(j)  (2304 + 64 * (j))
#define XB_TOP      3328
#define XB_TOPGEN   3392
#define XCD_BAR_WORDS 3456
#define XB_SPIN_CAP (1u << 18)

__device__ __forceinline__ unsigned xb_ld(unsigned* p)              { return __hip_atomic_load(p, __ATOMIC_RELAXED, __HIP_MEMORY_SCOPE_AGENT); }
__device__ __forceinline__ unsigned xb_add(unsigned* p, unsigned v) { return __hip_atomic_fetch_add(p, v, __ATOMIC_RELAXED, __HIP_MEMORY_SCOPE_AGENT); }
__device__ __forceinline__ unsigned xb_xcc_id() { return (unsigned)__builtin_amdgcn_s_getreg((3 << 11) | 20) & 0xFu; }
#define XB_SPIN(cond, bar) do { unsigned _sp = 0; while (cond) { __builtin_amdgcn_s_sleep(1); \
    if ((++_sp & 255u) == 0u) { if (xb_ld(&(bar)[XB_TMO])) break; if (_sp > XB_SPIN_CAP) { atomicAdd(&(bar)[XB_TMO], 1u); break; } } } } while (0)

struct XcdBarrier {
    unsigned* bar; unsigned x;
    volatile LAS unsigned* st;
};

__device__ __forceinline__ XcdBarrier xcd_barrier_post(unsigned* bar, volatile LAS unsigned* st) {
    XcdBarrier b; b.bar = bar; b.x = xb_xcc_id(); b.st = st;
    if (threadIdx.x == 0) (void)xb_add(&bar[XB_XCNT(b.x)], 1u);
    return b;
}
__device__ __forceinline__ void xcd_barrier_complete(unsigned* bar, unsigned x, unsigned& nloc, unsigned& nx) {
    const unsigned G = gridDim.x * gridDim.y * gridDim.z;
    unsigned sum, cnt, mine, sp = 0u;
    for (;;) {
        sum = 0u; cnt = 0u; mine = 0u;
#pragma unroll
        for (unsigned j = 0; j < 16; ++j) { const unsigned c = xb_ld(&bar[XB_XCNT(j)]); sum += c; cnt += (c > 0u) ? 1u : 0u; mine = (j == x) ? c : mine; }
        if (sum == G) break;
        __builtin_amdgcn_s_sleep(1);
        if ((++sp & 255u) == 0u) { if (xb_ld(&bar[XB_TMO])) break; if (sp > XB_SPIN_CAP) { atomicAdd(&bar[XB_TMO], 1u); break; } }
    }
    nloc = mine > 0u ? mine : 1u; nx = cnt > 0u ? cnt : 1u;
}

__device__ __forceinline__ void xcd_barrier(const XcdBarrier& b) {
    asm volatile("s_waitcnt vmcnt(0)" ::: "memory");
    __syncthreads();
    if (threadIdx.x == 0) {
        unsigned* bar = b.bar;
        __builtin_amdgcn_s_waitcnt(0);
        unsigned nloc = b.st[0], nx = b.st[1];
        if (nloc == 0u) { xcd_barrier_complete(bar, b.x, nloc, nx); b.st[0] = nloc; b.st[1] = nx; }
        const unsigned old = xb_add(&bar[XB_XSUB(b.x)], 1u);
        const unsigned gen = old / nloc;
        if (old + 1u == (gen + 1u) * nloc) {
            __builtin_amdgcn_fence(__ATOMIC_RELEASE, "agent");
            asm volatile("s_waitcnt vmcnt(0)" ::: "memory");
            const unsigned og = xb_add(&bar[XB_TOP], 1u);
            const unsigned tg = og / nx;
            if (og + 1u == (tg + 1u) * nx) xb_add(&bar[XB_TOPGEN], 1u);
            else XB_SPIN(xb_ld(&bar[XB_TOPGEN]) == tg, bar);
            __builtin_amdgcn_fence(__ATOMIC_ACQUIRE, "agent");
            xb_add(&bar[XB_XGEN(b.x)], 1u);
            asm volatile("s_waitcnt vmcnt(0)" ::: "memory");
        } else {
            XB_SPIN(xb_ld(&bar[XB_XGEN(b.x)]) == gen, bar);
            __builtin_amdgcn_fence(__ATOMIC_ACQUIRE, "agent");
            asm volatile("s_waitcnt vmcnt(0)" ::: "memory");
        }
    }
    __syncthreads();
}


constexpr int NWAVES = 8;
constexpr int D_MODEL = 2048, SEQ = 4096, DEPTH = 2, D_FF = 8192, PROJ = 5680, NIN = 5888;
constexpr int MP = 8192, MS = 64, MROWS = MP + MS, MPAD = 8448;
constexpr int NBLK_P = 64;
constexpr float ALPHA = 1.41421356237309515f, LN_EPS = 1e-5f;
constexpr size_t O0 = 0, O1 = 16777216, O2 = 16908288, O3 = 25296896, O4 = 33685504, O5 = 34734080, O6 = 34742272, O7 = 34807808, O8 = 34873344, O9 = 39067648, OEND = 39100416;
constexpr int PH_PRO = 0, PH_PER_LAYER = 8, N_PHASES = 1 + PH_PER_LAYER * DEPTH;
#ifndef MK_SPLIT
#define MK_SPLIT 0
#endif

constexpr size_t al256(size_t x) { return (x + 255) & ~(size_t)255; }
constexpr size_t WS_CTL = 0, CTL_ZERO_BYTES = 1u << 20;
constexpr size_t SZ_WIN = (size_t)NIN * D_MODEL * 2, SZ_WOUT = (size_t)D_MODEL * D_MODEL * 2, SZ_W1 = (size_t)D_FF * D_MODEL * 2, SZ_W2 = SZ_W1;
constexpr size_t WS_WIN = CTL_ZERO_BYTES, WS_WOUT = WS_WIN + DEPTH * SZ_WIN, WS_W1 = WS_WOUT + DEPTH * SZ_WOUT, WS_W2 = WS_W1 + DEPTH * SZ_W1;
constexpr size_t WS_XB = WS_W2 + DEPTH * SZ_W2;
constexpr size_t WS_XF = WS_XB + (size_t)MPAD * D_MODEL * 2;
constexpr size_t WS_Q = WS_XF + (size_t)MPAD * D_MODEL * 4;
constexpr size_t WS_KVC = WS_Q + (size_t)MPAD * 1024 * 2;
constexpr size_t WS_KVS = WS_KVC + (size_t)MPAD * 512 * 2, WS_KVW = WS_KVS + (size_t)MPAD * 512 * 2;
constexpr size_t WS_G = WS_KVW + (size_t)MPAD * 512 * 2;
constexpr size_t WS_Z = al256(WS_G + (size_t)MPAD * 48 * 4);
constexpr size_t WS_BG = WS_Z + (size_t)MPAD * 1024 * 2;
constexpr size_t WS_A2 = WS_BG + (size_t)MPAD * 1024 * 2;
constexpr size_t WS_MIX = WS_A2 + (size_t)MPAD * D_MODEL * 2;
constexpr size_t WS_H = WS_MIX + (size_t)MPAD * D_MODEL * 4;
constexpr size_t WS_HB = WS_H + (size_t)MPAD * D_MODEL * 4;
constexpr size_t WS_ACT = WS_HB + (size_t)MPAD * D_MODEL * 2;
constexpr size_t WS_F = WS_ACT + (size_t)MP * D_FF * 2;
constexpr size_t WS_KCP = WS_F + (size_t)MP * D_MODEL * 4;
constexpr size_t WS_KCS = WS_KCP + (size_t)2 * NBLK_P * 512 * 2;
constexpr size_t WS_PARTO = WS_KCS + (size_t)DEPTH * 8 * 256 * 512 * 4;
constexpr size_t WS_PART1 = WS_PARTO + (size_t)16 * 64 * 2048 * 4;
constexpr size_t WS_PART2 = WS_PART1 + (size_t)4 * 64 * 8192 * 4;
constexpr size_t WS_END = WS_PART2 + (size_t)16 * 64 * 2048 * 4;
constexpr int CW_TMO = 0, CW_BAR = 4096;

constexpr int RING_OFF = 0, RING_BYTES = 131072;
constexpr int LDSCTL_OFF = RING_BYTES, MISC_OFF = LDSCTL_OFF + 320;
constexpr int LDS_BYTES = 147456;

__device__ __forceinline__ float bf2f(unsigned short h) { return __uint_as_float((unsigned)h << 16); }

struct Frame {
    LAS unsigned char* lds;
    volatile LAS unsigned* MISC;
    gu32* ctl;
    int tid, lane, wave;
    int vcu, G;
    unsigned char* ws;
    float* out;
    const float *x_prompt, *x_sample, *cache_cmp, *cache_slc, *cache_win, *state_conv, *w_in, *w_cmp_k, *w_cmp_v, *conv_w, *w_out, *ln1_g, *ln1_b, *w1, *w2, *ln2_g, *ln2_b;
    const int* page_table;
};

__device__ __forceinline__ float wave_sum(float v) {
#pragma unroll
    for (int o = 1; o < 64; o <<= 1) v += __shfl_xor(v, o);
    return v;
}
__device__ __forceinline__ float wave_max(float v) {
#pragma unroll
    for (int o = 1; o < 64; o <<= 1) v = fmaxf(v, __shfl_xor(v, o));
    return v;
}

__device__ __forceinline__ void p0_transpose_item(const float* W, int ldn, int K, int src_col0, int ncols, bf16* WT, int dst_row0, LAS float* scr, int k0, int lane) {
#pragma unroll 8
    for (int i = 0; i < 32; ++i) { const int kk = 2 * i + (lane >> 5), n = lane & 31; scr[kk * 33 + n] = (n < ncols) ? W[(size_t)(k0 + kk) * ldn + src_col0 + n] : 0.f; }
    LDS_WAIT(); asm volatile("" ::: "memory");
    const int c = lane & 7;
#pragma unroll
    for (int j = 0; j < 4; ++j) { const int n = (lane >> 3) + 8 * j; const LAS float* s = scr + (8 * c) * 33 + n;
        v4u o; o.x = pk2(s[0 * 33], s[1 * 33]); o.y = pk2(s[2 * 33], s[3 * 33]); o.z = pk2(s[4 * 33], s[5 * 33]); o.w = pk2(s[6 * 33], s[7 * 33]);
        *(GAS v4u*)(WT + (size_t)(dst_row0 + n) * K + k0 + 8 * c) = o; }
    LDS_WAIT(); asm volatile("" ::: "memory");
}
__device__ __forceinline__ void win_block_src(int rb, int& src, int& ncols) {
    ncols = 32;
    if (rb < 80) { src = rb * 32; return; }
    if (rb < 144) { const int i = (rb - 80) >> 3, wb = (rb - 80) & 7; src = (wb < 4) ? (2608 + 128 * i + 32 * wb) : (4656 + 128 * i + 32 * (wb - 4)); return; }
    if (rb < 176) { src = 3632 + (rb - 144) * 32; return; }
    if (rb == 176) { src = 2560; return; }
    if (rb == 177) { src = 2592; ncols = 16; return; }
    src = 0; ncols = 0;
}
__device__ __forceinline__ void p0_prologue(Frame& F) {
    LAS float* scr = (LAS float*)(F.lds + RING_OFF + F.wave * 16384);
    const int gw = F.vcu * NWAVES + F.wave, NGW = F.G * NWAVES;
    constexpr int I_IN = (NIN / 32) * (D_MODEL / 64), I_OUT = (D_MODEL / 32) * (D_MODEL / 64), I_1 = (D_FF / 32) * (D_MODEL / 64), I_2 = (D_MODEL / 32) * (D_FF / 64);
    constexpr int I_LAYER = I_IN + I_OUT + I_1 + I_2;
    for (int it = gw; it < DEPTH * I_LAYER; it += NGW) {
        const int l = it / I_LAYER; int r = it - l * I_LAYER;
        if (r < I_IN) { const int rb = r % (NIN / 32), kb = r / (NIN / 32); int src, nc; win_block_src(rb, src, nc);
            p0_transpose_item(F.w_in + (size_t)l * D_MODEL * PROJ, PROJ, D_MODEL, src, nc, (bf16*)(F.ws + WS_WIN + l * SZ_WIN), rb * 32, scr, kb * 64, F.lane); continue; }
        r -= I_IN;
        if (r < I_OUT) { const int rb = r % (D_MODEL / 32), kb = r / (D_MODEL / 32);
            p0_transpose_item(F.w_out + (size_t)l * D_MODEL * D_MODEL, D_MODEL, D_MODEL, rb * 32, 32, (bf16*)(F.ws + WS_WOUT + l * SZ_WOUT), rb * 32, scr, kb * 64, F.lane); continue; }
        r -= I_OUT;
        if (r < I_1) { const int rb = r % (D_FF / 32), kb = r / (D_FF / 32);
            p0_transpose_item(F.w1 + (size_t)l * D_MODEL * D_FF, D_FF, D_MODEL, rb * 32, 32, (bf16*)(F.ws + WS_W1 + l * SZ_W1), rb * 32, scr, kb * 64, F.lane); continue; }
        r -= I_1;
        { const int rb = r % (D_MODEL / 32), kb = r / (D_MODEL / 32);
            p0_transpose_item(F.w2 + (size_t)l * D_FF * D_MODEL, D_MODEL, D_FF, rb * 32, 32, (bf16*)(F.ws + WS_W2 + l * SZ_W2), rb * 32, scr, kb * 64, F.lane); }
    }
    for (int m = gw; m < MPAD; m += NGW) {
        GAS unsigned long long* o8 = (GAS unsigned long long*)((bf16*)(F.ws + WS_XB) + (size_t)m * D_MODEL) + F.lane;
        if (m < MROWS) { const float* xr = (m < MP) ? F.x_prompt + (size_t)m * D_MODEL : F.x_sample + (size_t)(m - MP) * D_MODEL;
#pragma unroll
            for (int j = 0; j < 8; ++j) { const f32x4 v = ((const GAS f32x4*)xr)[F.lane + 64 * j]; o8[64 * j] = (unsigned long long)pk2(v.x, v.y) | ((unsigned long long)pk2(v.z, v.w) << 32); }
        } else {
#pragma unroll
            for (int j = 0; j < 8; ++j) o8[64 * j] = 0ull; }
    }
    for (int it = gw; it < DEPTH * 8 * 256; it += NGW) {
        const int l = it >> 11, b = (it >> 8) & 7, n = it & 255;
        const int page = F.page_table[b * 128 + (n >> 1)];
        const float* src = F.cache_cmp + (((size_t)l * 1280 + page) * 128 + (n & 1) * 64) * 512 + F.lane * 8;
        const int kv = F.lane >> 5, d0 = (F.lane * 8) & 63;
        const float* w = (kv ? F.w_cmp_v : F.w_cmp_k) + (size_t)l * 4096 + d0;
        f32x4 a0 = {0.f, 0.f, 0.f, 0.f}, a1 = a0;
#pragma unroll 8
        for (int r = 0; r < 64; ++r) { const f32x4 v0 = *(const GAS f32x4*)(src + (size_t)r * 512), v1 = *(const GAS f32x4*)(src + (size_t)r * 512 + 4);
            const f32x4 w0 = *(const GAS f32x4*)(w + r * 64), w1 = *(const GAS f32x4*)(w + r * 64 + 4); a0 += v0 * w0; a1 += v1 * w1; }
        float* dst = (float*)(F.ws + WS_KCS) + (((size_t)l * 8 + b) * 256 + n) * 512 + F.lane * 8;
        *(GAS f32x4*)dst = a0; *(GAS f32x4*)(dst + 4) = a1;
    }
    { const size_t gt = (size_t)F.vcu * (NWAVES * 64) + F.tid, gs = (size_t)F.G * NWAVES * 64;
      for (size_t i = gt; i < (size_t)DEPTH * 8 * 504 * 128; i += gs) { const size_t lb = i / (504 * 128), rem = i - lb * (504 * 128);
          ((GAS f32x4*)(F.out + O8 + lb * 512 * 512))[rem] = ((const GAS f32x4*)(F.cache_win + lb * 512 * 512 + 8 * 512))[rem]; } }
}

__device__ __forceinline__ void cmp_prompt_phase(Frame& F, int l) {
    const int gw = F.vcu * NWAVES + F.wave, NGW = F.G * NWAVES;
    for (int it = gw; it < 2 * NBLK_P; it += NGW) {
        const float* src = F.out + O2 + ((size_t)l * MP + (size_t)it * 64) * 512 + F.lane * 8;
        const int kv = F.lane >> 5, d0 = (F.lane * 8) & 63;
        const float* w = (kv ? F.w_cmp_v : F.w_cmp_k) + (size_t)l * 4096 + d0;
        f32x4 a0 = {0.f, 0.f, 0.f, 0.f}, a1 = a0;
#pragma unroll 8
        for (int r = 0; r < 64; ++r) { const f32x4 v0 = *(const GAS f32x4*)(src + (size_t)r * 512), v1 = *(const GAS f32x4*)(src + (size_t)r * 512 + 4);
            const f32x4 w0 = *(const GAS f32x4*)(w + r * 64), w1 = *(const GAS f32x4*)(w + r * 64 + 4); a0 += v0 * w0; a1 += v1 * w1; }
        v4u o; o.x = pk2(a0.x, a0.y); o.y = pk2(a0.z, a0.w); o.z = pk2(a1.x, a1.y); o.w = pk2(a1.z, a1.w);
        *(GAS v4u*)((bf16*)(F.ws + WS_KCP) + (size_t)it * 512 + F.lane * 8) = o;
    }
}
__device__ __forceinline__ void conv_phase(Frame& F, int l) {
    const bf16* Z = (const bf16*)(F.ws + WS_Z); const bf16* BG = (const bf16*)(F.ws + WS_BG); bf16* A2 = (bf16*)(F.ws + WS_A2);
    const float* cw = F.conv_w + (size_t)l * 3 * 1024; const float* st = F.state_conv + (size_t)l * 8 * 2 * 1024;
    const size_t gt = (size_t)F.vcu * (NWAVES * 64) + F.tid, gs = (size_t)F.G * NWAVES * 64;
    for (size_t i = gt; i < (size_t)MROWS * 128; i += gs) {
        const int row = (int)(i >> 7), c = (int)(i & 127) * 8;
        int path, b, t; if (row < MP) { path = 0; b = row >> 12; t = row & 4095; } else { path = 1; b = (row - MP) >> 3; t = (row - MP) & 7; }
        float z0[8], z1[8], z2[8], bg[8];
        { const v4u a = *(const GAS v4u*)(Z + (size_t)row * 1024 + c), g = *(const GAS v4u*)(BG + (size_t)row * 1024 + c);
#pragma unroll
          for (int e = 0; e < 4; ++e) { z0[2 * e] = __uint_as_float(a[e] << 16); z0[2 * e + 1] = __uint_as_float(a[e] & 0xffff0000u); bg[2 * e] = __uint_as_float(g[e] << 16); bg[2 * e + 1] = __uint_as_float(g[e] & 0xffff0000u); } }
        if (t >= 1) { const v4u a = *(const GAS v4u*)(Z + (size_t)(row - 1) * 1024 + c);
#pragma unroll
            for (int e = 0; e < 4; ++e) { z1[2 * e] = __uint_as_float(a[e] << 16); z1[2 * e + 1] = __uint_as_float(a[e] & 0xffff0000u); } }
        else {
#pragma unroll
            for (int e = 0; e < 8; ++e) z1[e] = path ? st[((size_t)b * 2 + 1) * 1024 + c + e] : 0.f; }
        if (t >= 2) { const v4u a = *(const GAS v4u*)(Z + (size_t)(row - 2) * 1024 + c);
#pragma unroll
            for (int e = 0; e < 4; ++e) { z2[2 * e] = __uint_as_float(a[e] << 16); z2[2 * e + 1] = __uint_as_float(a[e] & 0xffff0000u); } }
        else {
#pragma unroll
            for (int e = 0; e < 8; ++e) z2[e] = path ? st[((size_t)b * 2 + (t == 1 ? 1 : 0)) * 1024 + c + e] : 0.f; }
        float y[8];
#pragma unroll
        for (int e = 0; e < 8; ++e) y[e] = bg[e] * (cw[2 * 1024 + c + e] * z0[e] + cw[1024 + c + e] * z1[e] + cw[c + e] * z2[e]);
        v4u o; o.x = pk2(y[0], y[1]); o.y = pk2(y[2], y[3]); o.z = pk2(y[4], y[5]); o.w = pk2(y[6], y[7]);
        *(GAS v4u*)(A2 + (size_t)row * D_MODEL + 1024 + c) = o;
    }
}
__device__ __forceinline__ void ln_phase(Frame& F, const float* resid_p, const float* resid_s, const float* main_p, const float* parts, int nparts, const float* gam, const float* bet, float* of_p, float* of_s, bf16* ob) {
    const int gw = F.vcu * NWAVES + F.wave, NGW = F.G * NWAVES;
    for (int m = gw; m < MROWS; m += NGW) {
        const float* rr = (m < MP) ? resid_p + (size_t)m * D_MODEL : resid_s + (size_t)(m - MP) * D_MODEL;
        f32x4 v[8]; float s = 0.f;
#pragma unroll
        for (int j = 0; j < 8; ++j) { const f32x4 a = ((const GAS f32x4*)rr)[F.lane + 64 * j]; f32x4 c;
            if (m < MP) c = ((const GAS f32x4*)(main_p + (size_t)m * D_MODEL))[F.lane + 64 * j];
            else { c = (f32x4){0.f, 0.f, 0.f, 0.f}; for (int p = 0; p < nparts; ++p) c += ((const GAS f32x4*)(parts + ((size_t)p * 64 + (m - MP)) * D_MODEL))[F.lane + 64 * j]; }
            v[j] = a * ALPHA + c; s += (v[j].x + v[j].y) + (v[j].z + v[j].w); }
        const float mean = wave_sum(s) * (1.f / D_MODEL); float s2 = 0.f;
#pragma unroll
        for (int j = 0; j < 8; ++j) { v[j] = v[j] - mean; s2 += (v[j].x * v[j].x + v[j].y * v[j].y) + (v[j].z * v[j].z + v[j].w * v[j].w); }
        const float rstd = 1.0f / sqrtf(wave_sum(s2) * (1.f / D_MODEL) + LN_EPS);
        float* of = (m < MP) ? of_p + (size_t)m * D_MODEL : of_s + (size_t)(m - MP) * D_MODEL;
        GAS unsigned long long* o8 = (GAS unsigned long long*)(ob + (size_t)m * D_MODEL) + F.lane;
#pragma unroll
        for (int j = 0; j < 8; ++j) { const f32x4 gg = ((const GAS f32x4*)gam)[F.lane + 64 * j], bb = ((const GAS f32x4*)bet)[F.lane + 64 * j];
            const f32x4 y = v[j] * rstd * gg + bb;
            ((GAS f32x4*)of)[F.lane + 64 * j] = y;
            o8[64 * j] = (unsigned long long)pk2(y.x, y.y) | ((unsigned long long)pk2(y.z, y.w) << 32); }
    }
}

template <int AMODE>
__device__ __forceinline__ void skinny_phase(Frame& F, const void* Ap, int lda, const bf16* Bt, int N, int K, int KS, float* part) {
    const int ntile = N / 128, ntask = ntile * KS, klen = K / KS;
    const int fr = F.lane & 15, fq = F.lane >> 4;
    for (int task = F.vcu; task < ntask; task += F.G) {
        const int nt = task % ntile, ks = task / ntile;
        const int n0 = nt * 128 + F.wave * 16, k0 = ks * klen;
        f32x4 acc[4];
#pragma unroll
        for (int mi = 0; mi < 4; ++mi) acc[mi] = (f32x4){0.f, 0.f, 0.f, 0.f};
        const bf16* bp = Bt + (size_t)(n0 + fr) * K + k0 + 8 * fq;
        for (int kk = 0; kk < klen; kk += 32) {
            const bf16x8 bfrag = *(const GAS bf16x8*)(bp + kk);
#pragma unroll
            for (int mi = 0; mi < 4; ++mi) {
                bf16x8 afrag;
                if (AMODE == 0) afrag = *(const GAS bf16x8*)((const bf16*)Ap + (size_t)(16 * mi + fr) * lda + k0 + kk + 8 * fq);
                else { const float* a = (const float*)Ap + (size_t)(16 * mi + fr) * lda + k0 + kk + 8 * fq;
                    f32x4 s0 = {0.f, 0.f, 0.f, 0.f}, s1 = s0;
#pragma unroll
                    for (int p = 0; p < 4; ++p) { s0 += *(const GAS f32x4*)(a + (size_t)p * 64 * lda); s1 += *(const GAS f32x4*)(a + (size_t)p * 64 * lda + 4); }
#pragma unroll
                    for (int e = 0; e < 4; ++e) { const float u0 = fmaxf(s0[e], 0.f), u1 = fmaxf(s1[e], 0.f); s0[e] = u0 * u0; s1[e] = u1 * u1; }
                    v4u w; w.x = pk2(s0.x, s0.y); w.y = pk2(s0.z, s0.w); w.z = pk2(s1.x, s1.y); w.w = pk2(s1.z, s1.w);
                    afrag = __builtin_bit_cast(bf16x8, w); }
                acc[mi] = __builtin_amdgcn_mfma_f32_16x16x32_bf16(afrag, bfrag, acc[mi], 0, 0, 0);
            }
        }
#pragma unroll
        for (int mi = 0; mi < 4; ++mi)
#pragma unroll
            for (int r = 0; r < 4; ++r) part[((size_t)ks * 64 + 16 * mi + 4 * fq + r) * N + n0 + fr] = acc[mi][r];
    }
}

struct KvRow { const float* f; const bf16* h; };
__device__ __forceinline__ float kv_at(const KvRow& r, int i) { return r.f ? r.f[i] : bf2f(r.h[i]); }
__device__ __forceinline__ KvRow slc_row(Frame& F, int l, int path, int b, int pos) {
    KvRow r; r.f = nullptr; r.h = nullptr;
    if (!path) r.h = (const bf16*)(F.ws + WS_KVS) + (size_t)(b * SEQ + pos) * 512;
    else if (pos < 16384) r.f = F.cache_slc + (((size_t)l * 1280 + F.page_table[b * 128 + (pos >> 7)]) * 128 + (pos & 127)) * 512;
    else r.h = (const bf16*)(F.ws + WS_KVS) + (size_t)(MP + b * 8 + (pos - 16384)) * 512;
    return r;
}
__device__ __forceinline__ KvRow win_row(Frame& F, int l, int path, int b, int pos) {
    KvRow r; r.f = nullptr; r.h = nullptr;
    if (!path) r.h = (const bf16*)(F.ws + WS_KVW) + (size_t)(b * SEQ + pos) * 512;
    else { const int i = pos - 15872;
        if (i < 512) r.f = F.cache_win + (((size_t)l * 8 + b) * 512 + i) * 512;
        else r.h = (const bf16*)(F.ws + WS_KVW) + (size_t)(MP + b * 8 + (i - 512)) * 512; }
    return r;
}
__device__ __forceinline__ void dot4(const LAS float* q, const KvRow& r, int goff, float& s0, float& s1, float& s2, float& s3) {
    float a0 = 0.f, a1 = 0.f, a2 = 0.f, a3 = 0.f;
    if (r.f) {
#pragma unroll 4
        for (int i = 0; i < 16; ++i) { const f32x4 k = *(const GAS f32x4*)(r.f + goff + 4 * i);
#pragma unroll
            for (int e = 0; e < 4; ++e) { a0 = fmaf(q[4 * i + e], k[e], a0); a1 = fmaf(q[64 + 4 * i + e], k[e], a1); a2 = fmaf(q[128 + 4 * i + e], k[e], a2); a3 = fmaf(q[192 + 4 * i + e], k[e], a3); } }
    } else {
#pragma unroll 2
        for (int i = 0; i < 8; ++i) { const v4u w = *(const GAS v4u*)(r.h + goff + 8 * i);
#pragma unroll
            for (int e = 0; e < 4; ++e) { const float k0 = __uint_as_float(w[e] << 16), k1 = __uint_as_float(w[e] & 0xffff0000u); const int d = 8 * i + 2 * e;
                a0 = fmaf(q[d], k0, a0); a1 = fmaf(q[64 + d], k0, a1); a2 = fmaf(q[128 + d], k0, a2); a3 = fmaf(q[192 + d], k0, a3);
                a0 = fmaf(q[d + 1], k1, a0); a1 = fmaf(q[64 + d + 1], k1, a1); a2 = fmaf(q[128 + d + 1], k1, a2); a3 = fmaf(q[192 + d + 1], k1, a3); } }
    }
    s0 = a0; s1 = a1; s2 = a2; s3 = a3;
}
__device__ __forceinline__ void softmax_rows(LAS float* S, int n, int wid, int lane) {
    if (wid < 4) {
        LAS float* s = S + wid * 1024;
        float m = -1e30f;
        for (int i = lane; i < n; i += 64) m = fmaxf(m, s[i]);
        m = wave_max(m);
        float sum = 0.f;
        for (int i = lane; i < n; i += 64) { const float v = s[i]; const float e = (v > -1e29f) ? __builtin_amdgcn_exp2f(v - m) : 0.f; s[i] = e; sum += e; }
        sum = wave_sum(sum);
        const float inv = 1.0f / fmaxf(sum, 1e-30f);
        for (int i = lane; i < n; i += 64) s[i] *= inv;
    }
}
__device__ __forceinline__ void attn_task(Frame& F, int l, int path, int b, int g, int t) {
    const int tid = F.tid, lane = F.lane, wid = F.wave;
    const int past = path ? 16384 : 0;
    const int row = path ? (MP + b * 8 + t) : (b * SEQ + t);
    const int pos = past + t, cur = pos >> 6;
    const int n_blk = path ? 257 : 64;
    LAS float* q = (LAS float*)(F.lds + RING_OFF);
    LAS float* S = q + 256;
    volatile LAS float* score = S + 4096;
    volatile LAS int* sel = (volatile LAS int*)(S + 4096 + 272);
    LAS float* red = S + 4096 + 272 + 16;
    __syncthreads();
    if (tid < 256) q[tid] = bf2f(((const bf16*)(F.ws + WS_Q))[(size_t)row * 1024 + g * 256 + tid]);
    __syncthreads();
    for (int idx = tid; idx < 4 * n_blk; idx += NWAVES * 64) {
        const int r = idx / n_blk, n = idx - r * n_blk;
        float s = -1e30f;
        if (n * 64 + 63 <= pos) { float a = 0.f; const LAS float* qq = q + r * 64;
            if (path) { const float* k = (const float*)(F.ws + WS_KCS) + (((size_t)l * 8 + b) * 256 + n) * 512 + g * 64;
#pragma unroll 8
                for (int d = 0; d < 64; ++d) a = fmaf(qq[d], k[d], a); }
            else { const bf16* k = (const bf16*)(F.ws + WS_KCP) + ((size_t)b * 64 + n) * 512 + g * 64;
#pragma unroll 8
                for (int d = 0; d < 64; ++d) a = fmaf(qq[d], bf2f(k[d]), a); }
            s = a; }
        S[r * 1024 + n] = s;
    }
    __syncthreads();
    softmax_rows(S, n_blk, wid, lane);
    __syncthreads();
    for (int n = tid; n < n_blk; n += NWAVES * 64) {
        const float imp = (S[n] + S[1024 + n]) + (S[2048 + n] + S[3072 + n]);
        const bool forced = (n == 0) || (n == cur) || (n == cur - 1);
        score[n] = forced ? 1e9f : (n <= cur ? imp : -1e9f);
    }
    float o_cmp = 0.f;
    const int r_ = (tid >> 6) & 3, d_ = tid & 63;
    if (tid < 256) { const int nv = path ? 256 : 64;
        for (int n = 0; n < nv; ++n) { const float p = S[r_ * 1024 + n]; if (p != 0.f) {
            const float v = path ? ((const float*)(F.ws + WS_KCS))[(((size_t)l * 8 + b) * 256 + n) * 512 + 256 + g * 64 + d_] : bf2f(((const bf16*)(F.ws + WS_KCP))[((size_t)b * 64 + n) * 512 + 256 + g * 64 + d_]);
            o_cmp = fmaf(p, v, o_cmp); } } }
    __syncthreads();
    if (wid == 0) {
        for (int j = 0; j < 16; ++j) {
            float best = -3.0e38f; int bi = 0x7fffffff;
            for (int n = lane; n < n_blk; n += 64) { const float v = score[n]; if (v > best) { best = v; bi = n; } }
#pragma unroll
            for (int o = 1; o < 64; o <<= 1) { const float ov = __shfl_xor(best, o); const int oi = __shfl_xor(bi, o); if (ov > best || (ov == best && oi < bi)) { best = ov; bi = oi; } }
            if (lane == 0) { sel[j] = bi; score[bi] = -3.4e38f; }
            __builtin_amdgcn_fence(__ATOMIC_RELEASE, "wavefront"); __builtin_amdgcn_wave_barrier(); __builtin_amdgcn_fence(__ATOMIC_ACQUIRE, "wavefront");
        }
    }
    __syncthreads();
    for (int kidx = tid; kidx < 1024; kidx += NWAVES * 64) {
        const int kpos = sel[kidx >> 6] * 64 + (kidx & 63);
        float s0 = -1e30f, s1 = -1e30f, s2 = -1e30f, s3 = -1e30f;
        if (kpos <= pos) { const KvRow kr = slc_row(F, l, path, b, kpos); dot4(q, kr, g * 64, s0, s1, s2, s3); }
        S[kidx] = s0; S[1024 + kidx] = s1; S[2048 + kidx] = s2; S[3072 + kidx] = s3;
    }
    __syncthreads();
    softmax_rows(S, 1024, wid, lane);
    __syncthreads();
    float o_sel;
    { float a0 = 0.f, a1 = 0.f, a2 = 0.f, a3 = 0.f;
        for (int kidx = wid; kidx < 1024; kidx += NWAVES) { const float p0 = S[kidx], p1 = S[1024 + kidx], p2 = S[2048 + kidx], p3 = S[3072 + kidx];
            if (p0 != 0.f || p1 != 0.f || p2 != 0.f || p3 != 0.f) { const int kpos = sel[kidx >> 6] * 64 + (kidx & 63); const float v = kv_at(slc_row(F, l, path, b, kpos), 256 + g * 64 + lane);
                a0 = fmaf(p0, v, a0); a1 = fmaf(p1, v, a1); a2 = fmaf(p2, v, a2); a3 = fmaf(p3, v, a3); } }
        red[wid * 256 + lane] = a0; red[wid * 256 + 64 + lane] = a1; red[wid * 256 + 128 + lane] = a2; red[wid * 256 + 192 + lane] = a3;
        __syncthreads();
        float s = 0.f; if (tid < 256) { for (int k = 0; k < NWAVES; ++k) s += red[k * 256 + tid]; }
        o_sel = s; }
    __syncthreads();
    const int wp0 = path ? 15872 : 0;
    for (int i = tid; i < 512; i += NWAVES * 64) {
        const int kpos = pos - 511 + i;
        float s0 = -1e30f, s1 = -1e30f, s2 = -1e30f, s3 = -1e30f;
        if (kpos >= wp0) { const KvRow kr = win_row(F, l, path, b, kpos); dot4(q, kr, g * 64, s0, s1, s2, s3); }
        S[i] = s0; S[1024 + i] = s1; S[2048 + i] = s2; S[3072 + i] = s3;
    }
    __syncthreads();
    softmax_rows(S, 512, wid, lane);
    __syncthreads();
    { float a0 = 0.f, a1 = 0.f, a2 = 0.f, a3 = 0.f;
        for (int i = wid; i < 512; i += NWAVES) { const float p0 = S[i], p1 = S[1024 + i], p2 = S[2048 + i], p3 = S[3072 + i];
            if (p0 != 0.f || p1 != 0.f || p2 != 0.f || p3 != 0.f) { const float v = kv_at(win_row(F, l, path, b, pos - 511 + i), 256 + g * 64 + lane);
                a0 = fmaf(p0, v, a0); a1 = fmaf(p1, v, a1); a2 = fmaf(p2, v, a2); a3 = fmaf(p3, v, a3); } }
        red[wid * 256 + lane] = a0; red[wid * 256 + 64 + lane] = a1; red[wid * 256 + 128 + lane] = a2; red[wid * 256 + 192 + lane] = a3;
        __syncthreads();
        if (tid < 256) { float o_win = 0.f; for (int k = 0; k < NWAVES; ++k) o_win += red[k * 256 + tid];
            const float* gp = (const float*)(F.ws + WS_G) + (size_t)row * 48 + g * 12 + r_ * 3;
            const float val = gp[0] * o_cmp + gp[1] * o_sel + gp[2] * o_win;
            ((bf16*)(F.ws + WS_A2))[(size_t)row * D_MODEL + g * 256 + r_ * 64 + d_] = (bf16)f2bf(val); }
    }
}
__device__ __forceinline__ void attn_phase_scalar(Frame& F, int l) {
    const int ntask = (MP + MS) * 4;
    for (int task = F.vcu; task < ntask; task += F.G) {
        int path, b, t, g;
        if (task < MP * 4) { path = 0; g = task & 3; const int row = task >> 2; b = row >> 12; t = row & 4095; }
        else { path = 1; const int k = task - MP * 4; g = k & 3; const int row = k >> 2; b = row >> 3; t = row & 7; }
        attn_task(F, l, path, b, g, t);
    }
    __syncthreads();
}

struct Args { const void* in[18]; float* out; unsigned char* ws; int ph_lo, ph_hi; };
__global__ void __launch_bounds__(NWAVES * 64, 2) nsa_fwd(Args args) {
    extern __shared__ __attribute__((aligned(16))) unsigned char lds[];
    Frame F;
    F.lds = (LAS unsigned char*)lds;
    F.MISC = (volatile LAS unsigned*)(F.lds + MISC_OFF);
    F.tid = threadIdx.x; F.lane = F.tid & 63; F.wave = __builtin_amdgcn_readfirstlane(F.tid >> 6);
    F.G = gridDim.x; { const int bx = blockIdx.x; F.vcu = (F.G % 8 == 0) ? (bx % 8) * (F.G / 8) + bx / 8 : bx; }
    F.ws = args.ws; F.out = args.out; F.ctl = (gu32*)(args.ws + WS_CTL);
    F.x_prompt = (const float*)args.in[0]; F.x_sample = (const float*)args.in[1]; F.cache_cmp = (const float*)args.in[2]; F.cache_slc = (const float*)args.in[3];
    F.cache_win = (const float*)args.in[4]; F.state_conv = (const float*)args.in[5]; F.page_table = (const int*)args.in[6]; F.w_in = (const float*)args.in[7];
    F.w_cmp_k = (const float*)args.in[8]; F.w_cmp_v = (const float*)args.in[9]; F.conv_w = (const float*)args.in[10]; F.w_out = (const float*)args.in[11];
    F.ln1_g = (const float*)args.in[12]; F.ln1_b = (const float*)args.in[13]; F.w1 = (const float*)args.in[14]; F.w2 = (const float*)args.in[15];
    F.ln2_g = (const float*)args.in[16]; F.ln2_b = (const float*)args.in[17];
    for (int u = F.tid; u < (LDS_BYTES - LDSCTL_OFF) / 4; u += NWAVES * 64) ((LAS unsigned*)(F.lds + LDSCTL_OFF))[u] = 0u;
    __syncthreads();
    XcdBarrier bar; bar.bar = (unsigned*)(F.ctl + CW_BAR); bar.x = 0; bar.st = nullptr;
    if (!MK_SPLIT) bar = xcd_barrier_post((unsigned*)(F.ctl + CW_BAR), F.MISC + 8);
    const int lo = args.ph_lo, hi = args.ph_hi;
#define IN(k) (lo <= (k) && (k) < hi)
#define FRESH() do { int t_ = threadIdx.x; asm volatile("" : "+v"(t_)); F.tid = t_; F.lane = t_ & 63; F.wave = __builtin_amdgcn_readfirstlane(t_ >> 6); } while (0)
#define SEAM(k) do { if (IN(k) && IN((k) + 1)) { if (!MK_SPLIT) xcd_barrier(bar); } } while (0)

    if (IN(PH_PRO)) { FRESH(); p0_prologue(F); }
    SEAM(PH_PRO);
    for (int l = 0; l < DEPTH; ++l) {
        const int pb = 1 + PH_PER_LAYER * l;
        bf16* XB = (bf16*)(F.ws + WS_XB); bf16* HB = (bf16*)(F.ws + WS_HB); bf16* A2 = (bf16*)(F.ws + WS_A2); bf16* ACT = (bf16*)(F.ws + WS_ACT);
        if (IN(pb + 0)) {
            pg8::Gemm g{XB, (const bf16*)(F.ws + WS_WIN + l * SZ_WIN), MPAD, NIN, D_MODEL}; pg8::StaticOrder S; S.init(MPAD, NIN, F.G, (int)blockIdx.x);
            pg8::EpiInProj E{(bf16*)(F.ws + WS_Q), (bf16*)(F.ws + WS_KVC), (bf16*)(F.ws + WS_Z), (bf16*)(F.ws + WS_BG), (float*)(F.ws + WS_G), F.out, l};
            pg8::gemm_phase<pg8::EpiInProj, pg8::StaticOrder, true, true>(F.lds + RING_OFF, g, S, E);
        }
        SEAM(pb + 0);
        if (IN(pb + 1)) { FRESH(); cmp_prompt_phase(F, l); FRESH(); conv_phase(F, l); }
        SEAM(pb + 1);
        if (IN(pb + 2)) { FRESH(); attn_phase_scalar(F, l); }
        SEAM(pb + 2);
        if (IN(pb + 3)) {
            pg8::Gemm g{A2, (const bf16*)(F.ws + WS_WOUT + l * SZ_WOUT), MP, D_MODEL, D_MODEL}; pg8::StaticOrder S; S.init(MP, D_MODEL, F.G, (int)blockIdx.x);
            pg8::EpiF32 E{(float*)(F.ws + WS_MIX), D_MODEL};
            pg8::gemm_phase<pg8::EpiF32, pg8::StaticOrder, true, true>(F.lds + RING_OFF, g, S, E);
            FRESH(); skinny_phase<0>(F, A2 + (size_t)MP * D_MODEL, D_MODEL, (const bf16*)(F.ws + WS_WOUT + l * SZ_WOUT), D_MODEL, D_MODEL, 16, (float*)(F.ws + WS_PARTO));
        }
        SEAM(pb + 3);
        if (IN(pb + 4)) {
            const float* rp = l == 0 ? F.x_prompt : (const float*)(F.ws + WS_XF); const float* rs = l == 0 ? F.x_sample : (const float*)(F.ws + WS_XF) + (size_t)MP * D_MODEL;
            FRESH(); ln_phase(F, rp, rs, (const float*)(F.ws + WS_MIX), (const float*)(F.ws + WS_PARTO), 16, F.ln1_g + (size_t)l * D_MODEL, F.ln1_b + (size_t)l * D_MODEL,
                     (float*)(F.ws + WS_H), (float*)(F.ws + WS_H) + (size_t)MP * D_MODEL, HB);
        }
        SEAM(pb + 4);
        if (IN(pb + 5)) {
            pg8::Gemm g{HB, (const bf16*)(F.ws + WS_W1 + l * SZ_W1), MP, D_FF, D_MODEL}; pg8::StaticOrder S; S.init(MP, D_FF, F.G, (int)blockIdx.x);
            pg8::EpiRelu2 E{ACT, D_FF};
            pg8::gemm_phase<pg8::EpiRelu2, pg8::StaticOrder, true, true>(F.lds + RING_OFF, g, S, E);
            FRESH(); skinny_phase<0>(F, HB + (size_t)MP * D_MODEL, D_MODEL, (const bf16*)(F.ws + WS_W1 + l * SZ_W1), D_FF, D_MODEL, 4, (float*)(F.ws + WS_PART1));
        }
        SEAM(pb + 5);
        if (IN(pb + 6)) {
            pg8::Gemm g{ACT, (const bf16*)(F.ws + WS_W2 + l * SZ_W2), MP, D_MODEL, D_FF}; pg8::StaticOrder S; S.init(MP, D_MODEL, F.G, (int)blockIdx.x);
            pg8::EpiF32 E{(float*)(F.ws + WS_F), D_MODEL};
            pg8::gemm_phase<pg8::EpiF32, pg8::StaticOrder, true, true>(F.lds + RING_OFF, g, S, E);
            FRESH(); skinny_phase<1>(F, (const float*)(F.ws + WS_PART1), D_FF, (const bf16*)(F.ws + WS_W2 + l * SZ_W2), D_MODEL, D_FF, 16, (float*)(F.ws + WS_PART2));
        }
        SEAM(pb + 6);
        if (IN(pb + 7)) {
            float* yp = (l == DEPTH - 1) ? F.out + O0 : (float*)(F.ws + WS_XF); float* ys = (l == DEPTH - 1) ? F.out + O1 : (float*)(F.ws + WS_XF) + (size_t)MP * D_MODEL;
            FRESH(); ln_phase(F, (const float*)(F.ws + WS_H), (const float*)(F.ws + WS_H) + (size_t)MP * D_MODEL, (const float*)(F.ws + WS_F), (const float*)(F.ws + WS_PART2), 16,
                     F.ln2_g + (size_t)l * D_MODEL, F.ln2_b + (size_t)l * D_MODEL, yp, ys, XB);
        }
        SEAM(pb + 7);
    }
#undef IN
#undef SEAM
}

extern "C" void kernel_launch(void* const* d_in, const int* in_sizes, int n_in, void* d_out, int out_size, void* d_ws, size_t ws_size, hipStream_t stream) {
    (void)in_sizes;
    static int grid = 0;
    if (grid == 0) {
        if (n_in != 18 || (size_t)out_size != OEND || ws_size < WS_END) { fprintf(stderr, "kernel_launch: unexpected problem shape (n_in %d out %d ws %zu need %zu)\n", n_in, out_size, ws_size, (size_t)WS_END); grid = -1; return; }
        int dev = 0, cus = 0, per_cu = 0;
        if (hipGetDevice(&dev) != hipSuccess || hipDeviceGetAttribute(&cus, hipDeviceAttributeMultiprocessorCount, dev) != hipSuccess) { grid = -1; return; }
        if (hipFuncSetAttribute((const void*)nsa_fwd, hipFuncAttributeMaxDynamicSharedMemorySize, LDS_BYTES) != hipSuccess) { fprintf(stderr, "kernel_launch: hipFuncSetAttribute failed\n"); grid = -1; return; }
        if (hipOccupancyMaxActiveBlocksPerMultiprocessor(&per_cu, (const void*)nsa_fwd, NWAVES * 64, LDS_BYTES) != hipSuccess || per_cu < 1) { fprintf(stderr, "kernel_launch: occupancy query says %d\n", per_cu); per_cu = 1; }
        (void)hipGetLastError();
        grid = cus;
    }
    if (grid < 0) return;
    if (hipMemsetAsync((char*)d_ws + WS_CTL, 0, CTL_ZERO_BYTES, stream) != hipSuccess) return;
    Args a{};
    for (int i = 0; i < 18; ++i) a.in[i] = d_in[i];
    a.out = (float*)d_out; a.ws = (unsigned char*)d_ws;
#if MK_SPLIT
    for (int p = 0; p < N_PHASES; ++p) { a.ph_lo = p; a.ph_hi = p + 1; hipLaunchKernelGGL(nsa_fwd, dim3(grid), dim3(NWAVES * 64), LDS_BYTES, stream, a); }
#else
    a.ph_lo = 0; a.ph_hi = N_PHASES;
    hipLaunchKernelGGL(nsa_fwd, dim3(grid), dim3(NWAVES * 64), LDS_BYTES, stream, a);
#endif
    const hipError_t le = hipPeekAtLastError();
    if (le != hipSuccess) fprintf(stderr, "kernel_launch: launch failed: %s\n", hipGetErrorName(le));
}
```

```cpp
#include <hip/hip_runtime.h>
#include <cstdio>
#include <cstdint>
namespace pg8 {
#define PG8_LAS __attribute__((address_space(3)))
typedef unsigned short bf16_t;
typedef short bf16x8 __attribute__((ext_vector_type(8)));
typedef float f32x4 __attribute__((ext_vector_type(4)));
typedef unsigned u32x4 __attribute__((ext_vector_type(4)));
constexpr int BM = 256, BK = 64, HALF = 128, HTB = HALF * BK * 2  , STAGE_BYTES = 8 * HTB, NXCD = 8, WGM = 8;

__host__ __device__ __forceinline__ int lds_byte(int r, int c) { const int st = (r >> 4) * 2 + (c >> 5), rr = r & 15, cc = c & 31, ob = rr * 64 + cc * 2; return st * 1024 + (ob ^ (((ob >> 9) & 1) << 5)); }
__host__ __device__ __forceinline__ void stage_rc(int b, int& R, int& C) { const int st = b / 1024, sb = b % 1024, swz = sb ^ (((sb >> 9) & 1) << 5); R = (st >> 1) * 16 + swz / 64; C = (st & 1) * 32 + (swz % 64) / 2; }
__host__ __device__ __forceinline__ int perm32(int rho) { const int n = rho >> 4, i = rho & 15; return 8 * (i >> 2) + 4 * n + (i & 3); }

struct Unit { int pm, pn; };
struct Gemm { const bf16_t* A; const bf16_t* Bt; int M, N, K; };

struct StaticOrder {
    int nM, nN, nwg, G, c;
    __host__ __device__ void init(int M, int N, int G_, int c_) { nM = M / BM; nN = N / BM; nwg = nM * nN; G = G_; c = c_; }
    __host__ __device__ bool next(int i, Unit& u) const {
        const long L = (long)i * G + c; if (L >= nwg) return false;
        int wgid = (int)L; { const int q = nwg / NXCD, r = nwg % NXCD, xcd = wgid % NXCD, off = wgid / NXCD; wgid = (xcd < r ? xcd * (q + 1) : r * (q + 1) + (xcd - r) * q) + off; }
        const int nig = WGM * nN, gid = wgid / nig, fm = gid * WGM, gsz = (nM - fm) < WGM ? (nM - fm) : WGM;
        u.pm = fm + ((wgid % nig) % gsz); u.pn = (wgid % nig) / gsz; return true;
    }
    __device__ __forceinline__ void a_ready(const Unit&) const {}
    __device__ __forceinline__ void done(const Unit&) const {}
};

__device__ __forceinline__ unsigned cvt_pk_bf16(float lo, float hi) { unsigned r; asm volatile("v_cvt_pk_bf16_f32 %0, %1, %2" : "=v"(r) : "v"(lo), "v"(hi)); return r; }
__device__ __forceinline__ u32x4 pack8(const f32x4 v0, const f32x4 v1) { u32x4 w; w.x = cvt_pk_bf16(v0[0], v0[1]); w.y = cvt_pk_bf16(v0[2], v0[3]); w.z = cvt_pk_bf16(v1[0], v1[1]); w.w = cvt_pk_bf16(v1[2], v1[3]); return w; }

constexpr int EP_MROWS = 8256, EP_MP = 8192;
constexpr float EP_C2 = 0.125f * 1.4426950408889634f;
constexpr size_t EO2 = 16908288, EO3 = 25296896, EO4 = 33685504, EO5 = 34734080, EO6 = 34742272, EO7 = 34807808, EO8 = 34873344, EO9 = 39067648;

struct EpiInProj {
    static constexpr bool PERM = true, AFTER_DRAIN = false;
    bf16_t* Q; bf16_t* KV;   bf16_t* Z; bf16_t* BG; float* G; float* out; int layer;
    __device__ __forceinline__ void operator()(const f32x4 (&acc)[2][2][4][2], const Unit& u, int wr, int wc, int fr, int fq) const {
        const int pn = u.pn;
        const int row0 = u.pm * BM + wr * 64 + fr;
        if (pn < 4) {
#pragma unroll
            for (int ai = 0; ai < 2; ++ai)
#pragma unroll
                for (int m = 0; m < 4; ++m) { const int row = row0 + ai * HALF + m * 16; if (row < EP_MROWS) {
                    bf16_t* dst = Q + (size_t)row * 1024 + pn * 256 + wc * 32 + 8 * fq;
#pragma unroll
                    for (int bj = 0; bj < 2; ++bj) *(u32x4*)(dst + bj * HALF) = pack8(acc[ai][bj][m][0] * EP_C2, acc[ai][bj][m][1] * EP_C2); } }
        } else if (pn < 10) {
            const int which = (pn - 4) >> 1, cbase = ((pn - 4) & 1) * 256 + wc * 32 + 8 * fq;
            bf16_t* kvb = KV + (size_t)which * ((size_t)8448 * 512);
#pragma unroll
            for (int ai = 0; ai < 2; ++ai)
#pragma unroll
                for (int m = 0; m < 4; ++m) { const int row = row0 + ai * HALF + m * 16; if (row < EP_MROWS) {
                    float* fo = nullptr;
                    if (row < EP_MP) { const int b = row >> 12, t = row & 4095;
                        if (which == 0) fo = out + EO2 + ((size_t)layer * EP_MP + row) * 512;
                        else if (which == 1) fo = out + EO3 + ((size_t)layer * EP_MP + row) * 512;
                        else if (t >= 3584) fo = out + EO4 + (((size_t)layer * 2 + b) * 512 + (t - 3584)) * 512;
                    } else { const int s = row - EP_MP, b = s >> 3, t = s & 7;
                        if (which == 0) fo = out + EO6 + ((size_t)layer * 64 + s) * 512;
                        else if (which == 1) fo = out + EO7 + ((size_t)layer * 64 + s) * 512;
                        else fo = out + EO8 + (((size_t)layer * 8 + b) * 512 + 504 + t) * 512; }
#pragma unroll
                    for (int bj = 0; bj < 2; ++bj) { const int c = cbase + bj * HALF;
                        *(u32x4*)(kvb + (size_t)row * 512 + c) = pack8(acc[ai][bj][m][0], acc[ai][bj][m][1]);
                        if (fo) { *(f32x4*)(fo + c) = acc[ai][bj][m][0]; *(f32x4*)(fo + c + 4) = acc[ai][bj][m][1]; } } } }
        } else if (pn < 18) {
            const int c = (pn - 10) * 128 + wc * 32 + 8 * fq;
#pragma unroll
            for (int ai = 0; ai < 2; ++ai)
#pragma unroll
                for (int m = 0; m < 4; ++m) { const int row = row0 + ai * HALF + m * 16; if (row < EP_MROWS) {
                    const f32x4 z0 = acc[ai][0][m][0] * acc[ai][1][m][0], z1 = acc[ai][0][m][1] * acc[ai][1][m][1];
                    *(u32x4*)(Z + (size_t)row * 1024 + c) = pack8(z0, z1);
                    float* so = nullptr;
                    if (row < EP_MP) { const int b = row >> 12, t = row & 4095; if (t >= 4094) so = out + EO5 + (((size_t)layer * 2 + b) * 2 + (t - 4094)) * 1024 + c; }
                    else { const int s = row - EP_MP, b = s >> 3, t = s & 7; if (t >= 6) so = out + EO9 + (((size_t)layer * 8 + b) * 2 + (t - 6)) * 1024 + c; }
                    if (so) { *(f32x4*)so = z0; *(f32x4*)(so + 4) = z1; } } }
        } else if (pn < 22) {
#pragma unroll
            for (int ai = 0; ai < 2; ++ai)
#pragma unroll
                for (int m = 0; m < 4; ++m) { const int row = row0 + ai * HALF + m * 16; if (row < EP_MROWS) {
                    bf16_t* dst = BG + (size_t)row * 1024 + (pn - 18) * 256 + wc * 32 + 8 * fq;
#pragma unroll
                    for (int bj = 0; bj < 2; ++bj) *(u32x4*)(dst + bj * HALF) = pack8(acc[ai][bj][m][0], acc[ai][bj][m][1]); } }
        } else {
            if (wc == 0 || (wc == 1 && fq < 2)) {
#pragma unroll
                for (int ai = 0; ai < 2; ++ai)
#pragma unroll
                    for (int m = 0; m < 4; ++m) { const int row = row0 + ai * HALF + m * 16; if (row < EP_MROWS) {
                        float* dst = G + (size_t)row * 48 + wc * 32 + 8 * fq;
#pragma unroll
                        for (int n = 0; n < 2; ++n) { const f32x4 v = acc[ai][0][m][n]; f32x4 s;
#pragma unroll
                            for (int e = 0; e < 4; ++e) s[e] = 1.0f / (1.0f + __expf(-v[e]));
                            *(f32x4*)(dst + 4 * n) = s; } } }
            }
        }
    }
};

struct EpiF32 {
    static constexpr bool PERM = false, AFTER_DRAIN = false;
    float* C; int ldc;
    __device__ __forceinline__ void operator()(const f32x4 (&acc)[2][2][4][2], const Unit& u, int wr, int wc, int fr, int fq) const {
        const int row0 = u.pm * BM + wr * 64 + fr, col0 = u.pn * BM + wc * 32 + 4 * fq;
#pragma unroll
        for (int ai = 0; ai < 2; ++ai)
#pragma unroll
            for (int m = 0; m < 4; ++m) { float* rowp = C + (size_t)(row0 + ai * HALF + m * 16) * ldc + col0;
#pragma unroll
                for (int bj = 0; bj < 2; ++bj)
#pragma unroll
                    for (int n = 0; n < 2; ++n) *(f32x4*)(rowp + bj * HALF + n * 16) = acc[ai][bj][m][n]; }
    }
};

struct EpiRelu2 {
    static constexpr bool PERM = true, AFTER_DRAIN = false;
    bf16_t* O; int ldc;
    __device__ __forceinline__ void operator()(const f32x4 (&acc)[2][2][4][2], const Unit& u, int wr, int wc, int fr, int fq) const {
        const int row0 = u.pm * BM + wr * 64 + fr, col0 = u.pn * BM + wc * 32 + 8 * fq;
#pragma unroll
        for (int ai = 0; ai < 2; ++ai)
#pragma unroll
            for (int m = 0; m < 4; ++m) { bf16_t* rowp = O + (size_t)(row0 + ai * HALF + m * 16) * ldc + col0;
#pragma unroll
                for (int bj = 0; bj < 2; ++bj) { f32x4 v0 = acc[ai][bj][m][0], v1 = acc[ai][bj][m][1];
#pragma unroll
                    for (int e = 0; e < 4; ++e) { const float a = fmaxf(v0[e], 0.f), b = fmaxf(v1[e], 0.f); v0[e] = a * a; v1[e] = b * b; }
                    *(u32x4*)(rowp + bj * HALF) = pack8(v0, v1); } }
    }
};

template <class Epi, class Sched, bool ALIGN_EPI = false, bool SP2 = false>
__device__ __forceinline__ void gemm_phase(PG8_LAS unsigned char* lds, const Gemm g, const Sched& S, const Epi& E) {
    int tid_o = threadIdx.x; asm volatile("" : "+v"(tid_o));
    const int tid = tid_o, wid = __builtin_amdgcn_readfirstlane(tid >> 6), lane = tid & 63, wr = wid >> 2, wc = wid & 3, fr = lane & 15, fq = lane >> 4;
    const int K = g.K, nt = K / BK;
    unsigned voffA[2], voffB[2];
#pragma unroll
    for (int i = 0; i < 2; ++i) { int R, C; stage_rc(tid * 16 + i * 8192, R, C); const int Rb = Epi::PERM ? ((R & ~31) + perm32(R & 31)) : R;
        voffA[i] = (unsigned)(R * K + C) * 2u; voffB[i] = (unsigned)(Rb * K + C) * 2u; }
    const size_t kstep = (size_t)(BK * 2);
    const size_t hstep = (size_t)HALF * K * 2;
    const size_t tstep = 2 * hstep;
    const unsigned ldsw = (unsigned)wid * 1024u;
    const int aoff = lds_byte(wr * 64 + fr, fq * 8), boff = lds_byte(wc * 32 + fr, fq * 8);
#define PG8_SA(b, h) (((b) * 2 + (h)) * HTB)
#define PG8_SB(b, h) ((4 + (b) * 2 + (h)) * HTB)
#define PG8_STAGE(bufoff, gbase, voff) do { _Pragma("unroll") for (int _i = 0; _i < 2; ++_i) \
        __builtin_amdgcn_global_load_lds((const unsigned*)((const char*)(gbase) + (voff)[_i]), (PG8_LAS unsigned*)(lds + (bufoff) + ldsw + _i * 8192), 16, 0, 0); } while (0)
#define PG8_LDA(dst, b, h) do { _Pragma("unroll") for (int m = 0; m < 4; ++m) _Pragma("unroll") for (int k = 0; k < 2; ++k) dst[m][k] = *(const PG8_LAS bf16x8*)(lds + PG8_SA(b, h) + aoff + m * 2048 + k * 1024); } while (0)
#define PG8_LDB(dst, b, h) do { _Pragma("unroll") for (int n = 0; n < 2; ++n) _Pragma("unroll") for (int k = 0; k < 2; ++k) dst[n][k] = *(const PG8_LAS bf16x8*)(lds + PG8_SB(b, h) + boff + n * 2048 + k * 1024); } while (0)
#define PG8_MMA(ai, bj, At, Bt) do { __builtin_amdgcn_s_setprio(1); _Pragma("unroll") for (int m = 0; m < 4; ++m) _Pragma("unroll") for (int n = 0; n < 2; ++n) _Pragma("unroll") for (int k = 0; k < 2; ++k) \
        acc[ai][bj][m][n] = __builtin_amdgcn_mfma_f32_16x16x32_bf16(Bt[n][k], At[m][k], acc[ai][bj][m][n], 0, 0, 0); __builtin_amdgcn_s_setprio(0); } while (0)
#define PG8_WAIT_V(n) asm volatile("s_waitcnt vmcnt(" #n ")" ::: "memory")
#define PG8_WAIT_L(n) asm volatile("s_waitcnt lgkmcnt(" #n ")" ::: "memory")
#define PG8_BAR __builtin_amdgcn_s_barrier()
#define PG8_SCHED __builtin_amdgcn_sched_barrier(0)
    Unit cur, nxt; int ui = 0;
    if (!S.next(0, cur)) return;
    f32x4 acc[2][2][4][2];
#pragma unroll
    for (int a = 0; a < 2; ++a)
#pragma unroll
        for (int b = 0; b < 2; ++b)
#pragma unroll
            for (int m = 0; m < 4; ++m)
#pragma unroll
                for (int n = 0; n < 2; ++n) acc[a][b][m][n] = (f32x4){0.f, 0.f, 0.f, 0.f};
    bf16x8 At[4][2], B0[2][2], B1[2][2];
    const char* cA = (const char*)g.A + (size_t)cur.pm * tstep; const char* cB = (const char*)g.Bt + (size_t)cur.pn * tstep;
    S.a_ready(cur);
    if constexpr (SP2) {
        PG8_STAGE(PG8_SB(0, 0), cB, voffB); PG8_STAGE(PG8_SB(0, 1), cB + hstep, voffB); PG8_STAGE(PG8_SA(0, 0), cA, voffA); PG8_STAGE(PG8_SA(0, 1), cA + hstep, voffA);
        if (wr == 1) PG8_BAR;
        PG8_WAIT_V(2); PG8_BAR;
        PG8_STAGE(PG8_SB(1, 0), cB + kstep, voffB); PG8_STAGE(PG8_SA(1, 0), cA + kstep, voffA); PG8_STAGE(PG8_SB(1, 1), cB + hstep + kstep, voffB);
        PG8_WAIT_V(6); PG8_BAR;
    } else {
        PG8_STAGE(PG8_SB(0, 0), cB, voffB); PG8_STAGE(PG8_SA(0, 0), cA, voffA); PG8_STAGE(PG8_SB(0, 1), cB + hstep, voffB); PG8_STAGE(PG8_SA(0, 1), cA + hstep, voffA);
        if (wr == 1) PG8_BAR;
        PG8_WAIT_V(4); PG8_BAR;
        PG8_STAGE(PG8_SB(1, 0), cB + kstep, voffB); PG8_STAGE(PG8_SA(1, 0), cA + kstep, voffA); PG8_STAGE(PG8_SB(1, 1), cB + hstep + kstep, voffB);
        PG8_WAIT_V(6); PG8_BAR;
    }
    for (;;) {
        const bool has_next = S.next(ui + 1, nxt);
        const char* nA = has_next ? (const char*)g.A + (size_t)nxt.pm * tstep : cA; const char* nB = has_next ? (const char*)g.Bt + (size_t)nxt.pn * tstep : cB;
        for (int t = 0; t < nt; t += 2) {
            const bool last = (t == nt - 2);
            const char* a1 = cA + (size_t)(t + 1) * kstep;
            const char* a2 = last ? nA : cA + (size_t)(t + 2) * kstep; const char* b2 = last ? nB : cB + (size_t)(t + 2) * kstep;
            const char* a3 = a2 + kstep; const char* b3 = b2 + kstep;
            if (last && has_next) S.a_ready(nxt);
            if constexpr (SP2) {
            PG8_LDB(B0, 0, 0); PG8_LDB(B1, 0, 1); PG8_SCHED; PG8_LDA(At, 0, 0); PG8_STAGE(PG8_SA(1, 1), a1 + hstep, voffA);
            PG8_WAIT_V(8); PG8_WAIT_L(0); PG8_BAR; PG8_MMA(0, 0, At, B0); PG8_MMA(0, 1, At, B1); PG8_BAR; PG8_SCHED;
            PG8_LDA(At, 0, 1); PG8_STAGE(PG8_SB(0, 0), b2, voffB); PG8_STAGE(PG8_SB(0, 1), b2 + hstep, voffB); PG8_STAGE(PG8_SA(0, 0), a2, voffA);
            PG8_WAIT_V(8); PG8_WAIT_L(0); PG8_BAR; PG8_MMA(1, 0, At, B0); PG8_MMA(1, 1, At, B1); PG8_BAR; PG8_SCHED;
            PG8_LDB(B0, 1, 0); PG8_LDB(B1, 1, 1); PG8_SCHED; PG8_LDA(At, 1, 0); PG8_STAGE(PG8_SA(0, 1), a2 + hstep, voffA);
            PG8_WAIT_V(8); PG8_WAIT_L(0); PG8_BAR; PG8_MMA(0, 0, At, B0); PG8_MMA(0, 1, At, B1); PG8_BAR; PG8_SCHED;
            PG8_LDA(At, 1, 1); PG8_STAGE(PG8_SB(1, 0), b3, voffB); PG8_STAGE(PG8_SB(1, 1), b3 + hstep, voffB); PG8_STAGE(PG8_SA(1, 0), a3, voffA);
            PG8_WAIT_V(8); PG8_WAIT_L(0); PG8_BAR; PG8_MMA(1, 0, At, B0); PG8_MMA(1, 1, At, B1); PG8_BAR; PG8_SCHED;
            } else {
            PG8_LDB(B0, 0, 0); PG8_SCHED; PG8_LDA(At, 0, 0); PG8_STAGE(PG8_SA(1, 1), a1 + hstep, voffA);
            PG8_WAIT_L(8); PG8_BAR; PG8_WAIT_L(0); PG8_MMA(0, 0, At, B0); PG8_BAR; PG8_SCHED;
            PG8_LDB(B1, 0, 1); PG8_STAGE(PG8_SB(0, 0), b2, voffB);
            PG8_BAR; PG8_WAIT_L(0); PG8_MMA(0, 1, At, B1); PG8_BAR;
            PG8_LDA(At, 0, 1); PG8_STAGE(PG8_SA(0, 0), a2, voffA);
            PG8_BAR; PG8_WAIT_L(0); PG8_MMA(1, 0, At, B0); PG8_BAR; PG8_SCHED;
            PG8_STAGE(PG8_SB(0, 1), b2 + hstep, voffB);
            PG8_WAIT_V(6); PG8_BAR; PG8_MMA(1, 1, At, B1); PG8_BAR;
            PG8_LDB(B0, 1, 0); PG8_SCHED; PG8_LDA(At, 1, 0); PG8_STAGE(PG8_SA(0, 1), a2 + hstep, voffA);
            PG8_WAIT_L(8); PG8_BAR; PG8_WAIT_L(0); PG8_MMA(0, 0, At, B0); PG8_BAR; PG8_SCHED;
            PG8_LDB(B1, 1, 1); PG8_STAGE(PG8_SB(1, 0), b3, voffB);
            PG8_BAR; PG8_WAIT_L(0); PG8_MMA(0, 1, At, B1); PG8_BAR;
            PG8_LDA(At, 1, 1); PG8_STAGE(PG8_SA(1, 0), a3, voffA);
            PG8_BAR; PG8_WAIT_L(0); PG8_MMA(1, 0, At, B0); PG8_BAR; PG8_SCHED;
            PG8_STAGE(PG8_SB(1, 1), b3 + hstep, voffB);
            PG8_WAIT_V(6); PG8_BAR; PG8_MMA(1, 1, At, B1); PG8_BAR;
            }
        }
        if constexpr (ALIGN_EPI) { if (wr == 0) PG8_BAR; }
        if constexpr (!Epi::AFTER_DRAIN) { E(acc, cur, wr, wc, fr, fq); S.done(cur); }
        if (!has_next) break;
#pragma unroll
        for (int a = 0; a < 2; ++a)
#pragma unroll
            for (int b = 0; b < 2; ++b)
#pragma unroll
                for (int m = 0; m < 4; ++m)
#pragma unroll
                    for (int n = 0; n < 2; ++n) acc[a][b][m][n] = (f32x4){0.f, 0.f, 0.f, 0.f};
        cur = nxt; cA = nA; cB = nB; ++ui;
        if constexpr (ALIGN_EPI) { if (wr == 1) PG8_BAR; }
    }
    PG8_WAIT_V(0);
    if constexpr (!ALIGN_EPI) { if (wr == 0) PG8_BAR; }
    PG8_BAR;
    if constexpr (Epi::AFTER_DRAIN) { E.fused(acc, cur, wr, wc, fr, fq, lds, wid, lane); S.done(cur); }
#undef PG8_SA
#undef PG8_SB
#undef PG8_STAGE
#undef PG8_LDA
#undef PG8_LDB
#undef PG8_MMA
#undef PG8_WAIT_V
#undef PG8_WAIT_L
#undef PG8_BAR
#undef PG8_SCHED
}
}
#define GAS __attribute__((address_space(1)))
#define LAS __attribute__((address_space(3)))
typedef unsigned short bf16;
typedef unsigned v4u __attribute__((ext_vector_type(4)));
typedef float f32x4 __attribute__((ext_vector_type(4)));
typedef short bf16x8 __attribute__((ext_vector_type(8)));
typedef GAS unsigned gu32;
typedef GAS unsigned long long gu64;
#define RLX_AGENT __ATOMIC_RELAXED, __HIP_MEMORY_SCOPE_AGENT
#define LDS_WAIT() asm volatile("s_waitcnt lgkmcnt(0)" ::: "memory")
#define VM_WAIT() asm volatile("s_waitcnt vmcnt(0)" ::: "memory")
__device__ __forceinline__ unsigned long long rt() { return __builtin_amdgcn_s_memrealtime(); }
__device__ __forceinline__ unsigned f2bf(float f) { unsigned u = __builtin_bit_cast(unsigned, f); return (u + 0x7fffu + ((u >> 16) & 1u)) >> 16; }
__device__ __forceinline__ unsigned pk2(float lo, float hi) { return f2bf(lo) | (f2bf(hi) << 16); }

#define XB_TMO      128
#define XB_XCNT(j)  (256  + 64 * (j))
#define XB_XSUB(j)  (1280 + 64 * (j))
#define XB_XGEN(j)  (2304 + 64 * (j))
#define XB_TOP      3328
#define XB_TOPGEN   3392
#define XCD_BAR_WORDS 3456
#define XB_SPIN_CAP (1u << 18)

__device__ __forceinline__ unsigned xb_ld(unsigned* p)              { return __hip_atomic_load(p, __ATOMIC_RELAXED, __HIP_MEMORY_SCOPE_AGENT); }
__device__ __forceinline__ unsigned xb_add(unsigned* p, unsigned v) { return __hip_atomic_fetch_add(p, v, __ATOMIC_RELAXED, __HIP_MEMORY_SCOPE_AGENT); }
__device__ __forceinline__ unsigned xb_xcc_id() { return (unsigned)__builtin_amdgcn_s_getreg((3 << 11) | 20) & 0xFu; }
#define XB_SPIN(cond, bar) do { unsigned _sp = 0; while (cond) { __builtin_amdgcn_s_sleep(1); \
    if ((++_sp & 255u) == 0u) { if (xb_ld(&(bar)[XB_TMO])) break; if (_sp > XB_SPIN_CAP) { atomicAdd(&(bar)[XB_TMO], 1u); break; } } } } while (0)

struct XcdBarrier {
    unsigned* bar; unsigned x;
    volatile LAS unsigned* st;
};

__device__ __forceinline__ XcdBarrier xcd_barrier_post(unsigned* bar, volatile LAS unsigned* st) {
    XcdBarrier b; b.bar = bar; b.x = xb_xcc_id(); b.st = st;
    if (threadIdx.x == 0) (void)xb_add(&bar[XB_XCNT(b.x)], 1u);
    return b;
}
__device__ __forceinline__ void xcd_barrier_complete(unsigned* bar, unsigned x, unsigned& nloc, unsigned& nx) {
    const unsigned G = gridDim.x * gridDim.y * gridDim.z;
    unsigned sum, cnt, mine, sp = 0u;
    for (;;) {
        sum = 0u; cnt = 0u; mine = 0u;
#pragma unroll
        for (unsigned j = 0; j < 16; ++j) { const unsigned c = xb_ld(&bar[XB_XCNT(j)]); sum += c; cnt += (c > 0u) ? 1u : 0u; mine = (j == x) ? c : mine; }
        if (sum == G) break;
        __builtin_amdgcn_s_sleep(1);
        if ((++sp & 255u) == 0u) { if (xb_ld(&bar[XB_TMO])) break; if (sp > XB_SPIN_CAP) { atomicAdd(&bar[XB_TMO], 1u); break; } }
    }
    nloc = mine > 0u ? mine : 1u; nx = cnt > 0u ? cnt : 1u;
}

__device__ __forceinline__ void xcd_barrier(const XcdBarrier& b) {
    asm volatile("s_waitcnt vmcnt(0)" ::: "memory");
    __syncthreads();
    if (threadIdx.x == 0) {
        unsigned* bar = b.bar;
        __builtin_amdgcn_s_waitcnt(0);
        unsigned nloc = b.st[0], nx = b.st[1];
        if (nloc == 0u) { xcd_barrier_complete(bar, b.x, nloc, nx); b.st[0] = nloc; b.st[1] = nx; }
        const unsigned old = xb_add(&bar[XB_XSUB(b.x)], 1u);
        const unsigned gen = old / nloc;
        if (old + 1u == (gen + 1u) * nloc) {
            __builtin_amdgcn_fence(__ATOMIC_RELEASE, "agent");
            asm volatile("s_waitcnt vmcnt(0)" ::: "memory");
            const unsigned og = xb_add(&bar[XB_TOP], 1u);
            const unsigned tg = og / nx;
            if (og + 1u == (tg + 1u) * nx) xb_add(&bar[XB_TOPGEN], 1u);
            else XB_SPIN(xb_ld(&bar[XB_TOPGEN]) == tg, bar);
            __builtin_amdgcn_fence(__ATOMIC_ACQUIRE, "agent");
            xb_add(&bar[XB_XGEN(b.x)], 1u);
            asm volatile("s_waitcnt vmcnt(0)" ::: "memory");
        } else {
            XB_SPIN(xb_ld(&bar[XB_XGEN(b.x)]) == gen, bar);
            __builtin_amdgcn_fence(__ATOMIC_ACQUIRE, "agent");
            asm volatile("s_waitcnt vmcnt(0)" ::: "memory");
        }
    }
    __syncthreads();
}


constexpr int NWAVES = 8;
constexpr int D_MODEL = 2048, SEQ = 4096, DEPTH = 2, D_FF = 8192, PROJ = 5680, NIN = 5888;
constexpr int MP = 8192, MS = 64, MROWS = MP + MS, MPAD = 8448;
constexpr int NBLK_P = 64;
constexpr float ALPHA = 1.41421356237309515f, LN_EPS = 1e-5f;
constexpr size_t O0 = 0, O1 = 16777216, O2 = 16908288, O3 = 25296896, O4 = 33685504, O5 = 34734080, O6 = 34742272, O7 = 34807808, O8 = 34873344, O9 = 39067648, OEND = 39100416;
constexpr int PH_PRO = 0, PH_PER_LAYER = 8, N_PHASES = 1 + PH_PER_LAYER * DEPTH;
#ifndef MK_SPLIT
#define MK_SPLIT 0
#endif

constexpr size_t al256(size_t x) { return (x + 255) & ~(size_t)255; }
constexpr size_t WS_CTL = 0, CTL_ZERO_BYTES = 1u << 20;
constexpr size_t SZ_WIN = (size_t)NIN * D_MODEL * 2, SZ_WOUT = (size_t)D_MODEL * D_MODEL * 2, SZ_W1 = (size_t)D_FF * D_MODEL * 2, SZ_W2 = SZ_W1;
constexpr size_t WS_WIN = CTL_ZERO_BYTES, WS_WOUT = WS_WIN + DEPTH * SZ_WIN, WS_W1 = WS_WOUT + DEPTH * SZ_WOUT, WS_W2 = WS_W1 + DEPTH * SZ_W1;
constexpr size_t WS_XB = WS_W2 + DEPTH * SZ_W2;
constexpr size_t WS_XF = WS_XB + (size_t)MPAD * D_MODEL * 2;
constexpr size_t WS_Q = WS_XF + (size_t)MPAD * D_MODEL * 4;
constexpr size_t WS_KVC = WS_Q + (size_t)MPAD * 1024 * 2;
constexpr size_t WS_KVS = WS_KVC + (size_t)MPAD * 512 * 2, WS_KVW = WS_KVS + (size_t)MPAD * 512 * 2;
constexpr size_t WS_G = WS_KVW + (size_t)MPAD * 512 * 2;
constexpr size_t WS_Z = al256(WS_G + (size_t)MPAD * 48 * 4);
constexpr size_t WS_BG = WS_Z + (size_t)MPAD * 1024 * 2;
constexpr size_t WS_A2 = WS_BG + (size_t)MPAD * 1024 * 2;
constexpr size_t WS_MIX = WS_A2 + (size_t)MPAD * D_MODEL * 2;
constexpr size_t WS_H = WS_MIX + (size_t)MPAD * D_MODEL * 4;
constexpr size_t WS_HB = WS_H + (size_t)MPAD * D_MODEL * 4;
constexpr size_t WS_ACT = WS_HB + (size_t)MPAD * D_MODEL * 2;
constexpr size_t WS_F = WS_ACT + (size_t)MP * D_FF * 2;
constexpr size_t WS_KCP = WS_F + (size_t)MP * D_MODEL * 4;
constexpr size_t WS_KCS = WS_KCP + (size_t)2 * NBLK_P * 512 * 2;
constexpr size_t WS_PARTO = WS_KCS + (size_t)DEPTH * 8 * 256 * 512 * 4;
constexpr size_t WS_PART1 = WS_PARTO + (size_t)16 * 64 * 2048 * 4;
constexpr size_t WS_PART2 = WS_PART1 + (size_t)4 * 64 * 8192 * 4;
constexpr size_t WS_END = WS_PART2 + (size_t)16 * 64 * 2048 * 4;
constexpr int CW_TMO = 0, CW_BAR = 4096;

constexpr int RING_OFF = 0, RING_BYTES = 131072;
constexpr int LDSCTL_OFF = RING_BYTES, MISC_OFF = LDSCTL_OFF + 320, TAB_OFF = LDSCTL_OFF + 1024;
constexpr int LDS_BYTES = 147456;

__device__ __forceinline__ float bf2f(unsigned short h) { return __uint_as_float((unsigned)h << 16); }

struct Frame {
    LAS unsigned char* lds;
    volatile LAS unsigned* MISC;
    gu32* ctl;
    int tid, lane, wave;
    int vcu, G, bx;
    unsigned char* ws;
    float* out;
    volatile LAS unsigned long long* tab;
};
__device__ __forceinline__ const void* in_ptr(const Frame& F, int i) {
    const unsigned long long v = F.tab[i];
    const unsigned lo = __builtin_amdgcn_readfirstlane((unsigned)v), hi = __builtin_amdgcn_readfirstlane((unsigned)(v >> 32));
    return (const void*)(((unsigned long long)hi << 32) | lo);
}
#define INF_(i) ((const float*)in_ptr(F, (i)))
enum { I_XP = 0, I_XS, I_CCMP, I_CSLC, I_CWIN, I_SCONV, I_PT, I_WIN, I_WCK, I_WCV, I_CONVW, I_WOUT, I_LN1G, I_LN1B, I_W1, I_W2, I_LN2G, I_LN2B };

__device__ __forceinline__ float wave_sum(float v) {
#pragma unroll
    for (int o = 1; o < 64; o <<= 1) v += __shfl_xor(v, o);
    return v;
}
__device__ __forceinline__ float wave_max(float v) {
#pragma unroll
    for (int o = 1; o < 64; o <<= 1) v = fmaxf(v, __shfl_xor(v, o));
    return v;
}

__device__ __forceinline__ void p0_transpose_item(const float* W, int ldn, int K, int src_col0, int ncols, bf16* WT, int dst_row0, LAS float* scr, int k0, int lane) {
#pragma unroll 8
    for (int i = 0; i < 32; ++i) { const int kk = 2 * i + (lane >> 5), n = lane & 31; scr[kk * 33 + n] = (n < ncols) ? W[(size_t)(k0 + kk) * ldn + src_col0 + n] : 0.f; }
    LDS_WAIT(); asm volatile("" ::: "memory");
    const int c = lane & 7;
#pragma unroll
    for (int j = 0; j < 4; ++j) { const int n = (lane >> 3) + 8 * j; const LAS float* s = scr + (8 * c) * 33 + n;
        v4u o; o.x = pk2(s[0 * 33], s[1 * 33]); o.y = pk2(s[2 * 33], s[3 * 33]); o.z = pk2(s[4 * 33], s[5 * 33]); o.w = pk2(s[6 * 33], s[7 * 33]);
        *(GAS v4u*)(WT + (size_t)(dst_row0 + n) * K + k0 + 8 * c) = o; }
    LDS_WAIT(); asm volatile("" ::: "memory");
}
__device__ __forceinline__ void win_block_src(int rb, int& src, int& ncols) {
    ncols = 32;
    if (rb < 80) { src = rb * 32; return; }
    if (rb < 144) { const int i = (rb - 80) >> 3, wb = (rb - 80) & 7; src = (wb < 4) ? (2608 + 128 * i + 32 * wb) : (4656 + 128 * i + 32 * (wb - 4)); return; }
    if (rb < 176) { src = 3632 + (rb - 144) * 32; return; }
    if (rb == 176) { src = 2560; return; }
    if (rb == 177) { src = 2592; ncols = 16; return; }
    src = 0; ncols = 0;
}
__device__ __forceinline__ void p0_prologue(Frame& F) {
    LAS float* scr = (LAS float*)(F.lds + RING_OFF + F.wave * 16384);
    const int gw = F.vcu * NWAVES + F.wave, NGW = F.G * NWAVES;
    constexpr int I_IN = (NIN / 32) * (D_MODEL / 64), I_OUT = (D_MODEL / 32) * (D_MODEL / 64), I_1 = (D_FF / 32) * (D_MODEL / 64), I_2 = (D_MODEL / 32) * (D_FF / 64);
    constexpr int I_LAYER = I_IN + I_OUT + I_1 + I_2;
    for (int it = gw; it < DEPTH * I_LAYER; it += NGW) {
        const int l = it / I_LAYER; int r = it - l * I_LAYER;
        if (r < I_IN) { const int rb = r % (NIN / 32), kb = r / (NIN / 32); int src, nc; win_block_src(rb, src, nc);
            p0_transpose_item(INF_(I_WIN) + (size_t)l * D_MODEL * PROJ, PROJ, D_MODEL, src, nc, (bf16*)(F.ws + WS_WIN + l * SZ_WIN), rb * 32, scr, kb * 64, F.lane); continue; }
        r -= I_IN;
        if (r < I_OUT) { const int rb = r % (D_MODEL / 32), kb = r / (D_MODEL / 32);
            p0_transpose_item(INF_(I_WOUT) + (size_t)l * D_MODEL * D_MODEL, D_MODEL, D_MODEL, rb * 32, 32, (bf16*)(F.ws + WS_WOUT + l * SZ_WOUT), rb * 32, scr, kb * 64, F.lane); continue; }
        r -= I_OUT;
        if (r < I_1) { const int rb = r % (D_FF / 32), kb = r / (D_FF / 32);
            p0_transpose_item(INF_(I_W1) + (size_t)l * D_MODEL * D_FF, D_FF, D_MODEL, rb * 32, 32, (bf16*)(F.ws + WS_W1 + l * SZ_W1), rb * 32, scr, kb * 64, F.lane); continue; }
        r -= I_1;
        { const int rb = r % (D_MODEL / 32), kb = r / (D_MODEL / 32);
            p0_transpose_item(INF_(I_W2) + (size_t)l * D_FF * D_MODEL, D_MODEL, D_FF, rb * 32, 32, (bf16*)(F.ws + WS_W2 + l * SZ_W2), rb * 32, scr, kb * 64, F.lane); }
    }
    for (int m = gw; m < MPAD; m += NGW) {
        GAS unsigned long long* o8 = (GAS unsigned long long*)((bf16*)(F.ws + WS_XB) + (size_t)m * D_MODEL) + F.lane;
        if (m < MROWS) { const float* xr = (m < MP) ? INF_(I_XP) + (size_t)m * D_MODEL : INF_(I_XS) + (size_t)(m - MP) * D_MODEL;
#pragma unroll
            for (int j = 0; j < 8; ++j) { const f32x4 v = ((const GAS f32x4*)xr)[F.lane + 64 * j]; o8[64 * j] = (unsigned long long)pk2(v.x, v.y) | ((unsigned long long)pk2(v.z, v.w) << 32); }
        } else {
#pragma unroll
            for (int j = 0; j < 8; ++j) o8[64 * j] = 0ull; }
    }
    for (int it = gw; it < DEPTH * 8 * 256; it += NGW) {
        const int l = it >> 11, b = (it >> 8) & 7, n = it & 255;
        const int page = ((const int*)in_ptr(F, I_PT))[b * 128 + (n >> 1)];
        const float* src = INF_(I_CCMP) + (((size_t)l * 1280 + page) * 128 + (n & 1) * 64) * 512 + F.lane * 8;
        const int kv = F.lane >> 5, d0 = (F.lane * 8) & 63;
        const float* w = (kv ? INF_(I_WCV) : INF_(I_WCK)) + (size_t)l * 4096 + d0;
        f32x4 a0 = {0.f, 0.f, 0.f, 0.f}, a1 = a0;
#pragma unroll 8
        for (int r = 0; r < 64; ++r) { const f32x4 v0 = *(const GAS f32x4*)(src + (size_t)r * 512), v1 = *(const GAS f32x4*)(src + (size_t)r * 512 + 4);
            const f32x4 w0 = *(const GAS f32x4*)(w + r * 64), w1 = *(const GAS f32x4*)(w + r * 64 + 4); a0 += v0 * w0; a1 += v1 * w1; }
        float* dst = (float*)(F.ws + WS_KCS) + (((size_t)l * 8 + b) * 256 + n) * 512 + F.lane * 8;
        *(GAS f32x4*)dst = a0; *(GAS f32x4*)(dst + 4) = a1;
    }
    { const size_t gt = (size_t)F.vcu * (NWAVES * 64) + F.tid, gs = (size_t)F.G * NWAVES * 64;
      for (size_t i = gt; i < (size_t)DEPTH * 8 * 504 * 128; i += gs) { const size_t lb = i / (504 * 128), rem = i - lb * (504 * 128);
          ((GAS f32x4*)(F.out + O8 + lb * 512 * 512))[rem] = ((const GAS f32x4*)(INF_(I_CWIN) + lb * 512 * 512 + 8 * 512))[rem]; } }
}

__device__ __forceinline__ void cmp_prompt_phase(Frame& F, int l) {
    const int gw = F.vcu * NWAVES + F.wave, NGW = F.G * NWAVES;
    for (int it = gw; it < 2 * NBLK_P; it += NGW) {
        const float* src = F.out + O2 + ((size_t)l * MP + (size_t)it * 64) * 512 + F.lane * 8;
        const int kv = F.lane >> 5, d0 = (F.lane * 8) & 63;
        const float* w = (kv ? INF_(I_WCV) : INF_(I_WCK)) + (size_t)l * 4096 + d0;
        f32x4 a0 = {0.f, 0.f, 0.f, 0.f}, a1 = a0;
#pragma unroll 8
        for (int r = 0; r < 64; ++r) { const f32x4 v0 = *(const GAS f32x4*)(src + (size_t)r * 512), v1 = *(const GAS f32x4*)(src + (size_t)r * 512 + 4);
            const f32x4 w0 = *(const GAS f32x4*)(w + r * 64), w1 = *(const GAS f32x4*)(w + r * 64 + 4); a0 += v0 * w0; a1 += v1 * w1; }
        v4u o; o.x = pk2(a0.x, a0.y); o.y = pk2(a0.z, a0.w); o.z = pk2(a1.x, a1.y); o.w = pk2(a1.z, a1.w);
        *(GAS v4u*)((bf16*)(F.ws + WS_KCP) + (size_t)it * 512 + F.lane * 8) = o;
    }
}
__device__ __forceinline__ void conv_phase(Frame& F, int l) {
    const bf16* Z = (const bf16*)(F.ws + WS_Z); const bf16* BG = (const bf16*)(F.ws + WS_BG); bf16* A2 = (bf16*)(F.ws + WS_A2);
    const float* cw = INF_(I_CONVW) + (size_t)l * 3 * 1024; const float* st = INF_(I_SCONV) + (size_t)l * 8 * 2 * 1024;
    const size_t gt = (size_t)F.vcu * (NWAVES * 64) + F.tid, gs = (size_t)F.G * NWAVES * 64;
    for (size_t i = gt; i < (size_t)MROWS * 128; i += gs) {
        const int row = (int)(i >> 7), c = (int)(i & 127) * 8;
        int path, b, t; if (row < MP) { path = 0; b = row >> 12; t = row & 4095; } else { path = 1; b = (row - MP) >> 3; t = (row - MP) & 7; }
        float z0[8], z1[8], z2[8], bg[8];
        { const v4u a = *(const GAS v4u*)(Z + (size_t)row * 1024 + c), g = *(const GAS v4u*)(BG + (size_t)row * 1024 + c);
#pragma unroll
          for (int e = 0; e < 4; ++e) { z0[2 * e] = __uint_as_float(a[e] << 16); z0[2 * e + 1] = __uint_as_float(a[e] & 0xffff0000u); bg[2 * e] = __uint_as_float(g[e] << 16); bg[2 * e + 1] = __uint_as_float(g[e] & 0xffff0000u); } }
        if (t >= 1) { const v4u a = *(const GAS v4u*)(Z + (size_t)(row - 1) * 1024 + c);
#pragma unroll
            for (int e = 0; e < 4; ++e) { z1[2 * e] = __uint_as_float(a[e] << 16); z1[2 * e + 1] = __uint_as_float(a[e] & 0xffff0000u); } }
        else {
#pragma unroll
            for (int e = 0; e < 8; ++e) z1[e] = path ? st[((size_t)b * 2 + 1) * 1024 + c + e] : 0.f; }
        if (t >= 2) { const v4u a = *(const GAS v4u*)(Z + (size_t)(row - 2) * 1024 + c);
#pragma unroll
            for (int e = 0; e < 4; ++e) { z2[2 * e] = __uint_as_float(a[e] << 16); z2[2 * e + 1] = __uint_as_float(a[e] & 0xffff0000u); } }
        else {
#pragma unroll
            for (int e = 0; e < 8; ++e) z2[e] = path ? st[((size_t)b * 2 + (t == 1 ? 1 : 0)) * 1024 + c + e] : 0.f; }
        float y[8];
#pragma unroll
        for (int e = 0; e < 8; ++e) y[e] = bg[e] * (cw[2 * 1024 + c + e] * z0[e] + cw[1024 + c + e] * z1[e] + cw[c + e] * z2[e]);
        v4u o; o.x = pk2(y[0], y[1]); o.y = pk2(y[2], y[3]); o.z = pk2(y[4], y[5]); o.w = pk2(y[6], y[7]);
        *(GAS v4u*)(A2 + (size_t)row * D_MODEL + 1024 + c) = o;
    }
}
__device__ __forceinline__ void ln_phase(Frame& F, const float* resid_p, const float* resid_s, const float* main_p, const float* parts, int nparts, const float* gam, const float* bet, float* of_p, float* of_s, bf16* ob) {
    const int gw = F.vcu * NWAVES + F.wave, NGW = F.G * NWAVES;
    for (int m = gw; m < MROWS; m += NGW) {
        const float* rr = (m < MP) ? resid_p + (size_t)m * D_MODEL : resid_s + (size_t)(m - MP) * D_MODEL;
        f32x4 v[8]; float s = 0.f;
#pragma unroll
        for (int j = 0; j < 8; ++j) { const f32x4 a = ((const GAS f32x4*)rr)[F.lane + 64 * j]; f32x4 c;
            if (m < MP) c = ((const GAS f32x4*)(main_p + (size_t)m * D_MODEL))[F.lane + 64 * j];
            else { c = (f32x4){0.f, 0.f, 0.f, 0.f}; for (int p = 0; p < nparts; ++p) c += ((const GAS f32x4*)(parts + ((size_t)p * 64 + (m - MP)) * D_MODEL))[F.lane + 64 * j]; }
            v[j] = a * ALPHA + c; s += (v[j].x + v[j].y) + (v[j].z + v[j].w); }
        const float mean = wave_sum(s) * (1.f / D_MODEL); float s2 = 0.f;
#pragma unroll
        for (int j = 0; j < 8; ++j) { v[j] = v[j] - mean; s2 += (v[j].x * v[j].x + v[j].y * v[j].y) + (v[j].z * v[j].z + v[j].w * v[j].w); }
        const float rstd = 1.0f / sqrtf(wave_sum(s2) * (1.f / D_MODEL) + LN_EPS);
        float* of = (m < MP) ? of_p + (size_t)m * D_MODEL : of_s + (size_t)(m - MP) * D_MODEL;
        GAS unsigned long long* o8 = (GAS unsigned long long*)(ob + (size_t)m * D_MODEL) + F.lane;
#pragma unroll
        for (int j = 0; j < 8; ++j) { const f32x4 gg = ((const GAS f32x4*)gam)[F.lane + 64 * j], bb = ((const GAS f32x4*)bet)[F.lane + 64 * j];
            const f32x4 y = v[j] * rstd * gg + bb;
            ((GAS f32x4*)of)[F.lane + 64 * j] = y;
            o8[64 * j] = (unsigned long long)pk2(y.x, y.y) | ((unsigned long long)pk2(y.z, y.w) << 32); }
    }
}

template <int AMODE>
__device__ __forceinline__ void skinny_phase(Frame& F, const void* Ap, int lda, const bf16* Bt, int N, int K, int KS, float* part) {
    const int ntile = N / 128, ntask = ntile * KS, klen = K / KS;
    const int fr = F.lane & 15, fq = F.lane >> 4;
    for (int task = F.vcu; task < ntask; task += F.G) {
        const int nt = task % ntile, ks = task / ntile;
        const int n0 = nt * 128 + F.wave * 16, k0 = ks * klen;
        f32x4 acc[4];
#pragma unroll
        for (int mi = 0; mi < 4; ++mi) acc[mi] = (f32x4){0.f, 0.f, 0.f, 0.f};
        const bf16* bp = Bt + (size_t)(n0 + fr) * K + k0 + 8 * fq;
        for (int kk = 0; kk < klen; kk += 32) {
            const bf16x8 bfrag = *(const GAS bf16x8*)(bp + kk);
#pragma unroll
            for (int mi = 0; mi < 4; ++mi) {
                bf16x8 afrag;
                if (AMODE == 0) afrag = *(const GAS bf16x8*)((const bf16*)Ap + (size_t)(16 * mi + fr) * lda + k0 + kk + 8 * fq);
                else { const float* a = (const float*)Ap + (size_t)(16 * mi + fr) * lda + k0 + kk + 8 * fq;
                    f32x4 s0 = {0.f, 0.f, 0.f, 0.f}, s1 = s0;
#pragma unroll
                    for (int p = 0; p < 4; ++p) { s0 += *(const GAS f32x4*)(a + (size_t)p * 64 * lda); s1 += *(const GAS f32x4*)(a + (size_t)p * 64 * lda + 4); }
#pragma unroll
                    for (int e = 0; e < 4; ++e) { const float u0 = fmaxf(s0[e], 0.f), u1 = fmaxf(s1[e], 0.f); s0[e] = u0 * u0; s1[e] = u1 * u1; }
                    v4u w; w.x = pk2(s0.x, s0.y); w.y = pk2(s0.z, s0.w); w.z = pk2(s1.x, s1.y); w.w = pk2(s1.z, s1.w);
                    afrag = __builtin_bit_cast(bf16x8, w); }
                acc[mi] = __builtin_amdgcn_mfma_f32_16x16x32_bf16(afrag, bfrag, acc[mi], 0, 0, 0);
            }
        }
#pragma unroll
        for (int mi = 0; mi < 4; ++mi)
#pragma unroll
            for (int r = 0; r < 4; ++r) part[((size_t)ks * 64 + 16 * mi + 4 * fq + r) * N + n0 + fr] = acc[mi][r];
    }
}

struct KvRow { const float* f; const bf16* h; };
__device__ __forceinline__ float kv_at(const KvRow& r, int i) { return r.f ? r.f[i] : bf2f(r.h[i]); }
__device__ __forceinline__ KvRow slc_row(Frame& F, int l, int path, int b, int pos) {
    KvRow r; r.f = nullptr; r.h = nullptr;
    if (!path) r.h = (const bf16*)(F.ws + WS_KVS) + (size_t)(b * SEQ + pos) * 512;
    else if (pos < 16384) r.f = INF_(I_CSLC) + (((size_t)l * 1280 + ((const int*)in_ptr(F, I_PT))[b * 128 + (pos >> 7)]) * 128 + (pos & 127)) * 512;
    else r.h = (const bf16*)(F.ws + WS_KVS) + (size_t)(MP + b * 8 + (pos - 16384)) * 512;
    return r;
}
__device__ __forceinline__ KvRow win_row(Frame& F, int l, int path, int b, int pos) {
    KvRow r; r.f = nullptr; r.h = nullptr;
    if (!path) r.h = (const bf16*)(F.ws + WS_KVW) + (size_t)(b * SEQ + pos) * 512;
    else { const int i = pos - 15872;
        if (i < 512) r.f = INF_(I_CWIN) + (((size_t)l * 8 + b) * 512 + i) * 512;
        else r.h = (const bf16*)(F.ws + WS_KVW) + (size_t)(MP + b * 8 + (i - 512)) * 512; }
    return r;
}
__device__ __forceinline__ void dot4(const LAS float* q, const KvRow& r, int goff, float& s0, float& s1, float& s2, float& s3) {
    float a0 = 0.f, a1 = 0.f, a2 = 0.f, a3 = 0.f;
    if (r.f) {
#pragma unroll 4
        for (int i = 0; i < 16; ++i) { const f32x4 k = *(const GAS f32x4*)(r.f + goff + 4 * i);
#pragma unroll
            for (int e = 0; e < 4; ++e) { a0 = fmaf(q[4 * i + e], k[e], a0); a1 = fmaf(q[64 + 4 * i + e], k[e], a1); a2 = fmaf(q[128 + 4 * i + e], k[e], a2); a3 = fmaf(q[192 + 4 * i + e], k[e], a3); } }
    } else {
#pragma unroll 2
        for (int i = 0; i < 8; ++i) { const v4u w = *(const GAS v4u*)(r.h + goff + 8 * i);
#pragma unroll
            for (int e = 0; e < 4; ++e) { const float k0 = __uint_as_float(w[e] << 16), k1 = __uint_as_float(w[e] & 0xffff0000u); const int d = 8 * i + 2 * e;
                a0 = fmaf(q[d], k0, a0); a1 = fmaf(q[64 + d], k0, a1); a2 = fmaf(q[128 + d], k0, a2); a3 = fmaf(q[192 + d], k0, a3);
                a0 = fmaf(q[d + 1], k1, a0); a1 = fmaf(q[64 + d + 1], k1, a1); a2 = fmaf(q[128 + d + 1], k1, a2); a3 = fmaf(q[192 + d + 1], k1, a3); } }
    }
    s0 = a0; s1 = a1; s2 = a2; s3 = a3;
}
__device__ __forceinline__ void softmax_rows(LAS float* S, int n, int wid, int lane) {
    if (wid < 4) {
        LAS float* s = S + wid * 1024;
        float m = -1e30f;
        for (int i = lane; i < n; i += 64) m = fmaxf(m, s[i]);
        m = wave_max(m);
        float sum = 0.f;
        for (int i = lane; i < n; i += 64) { const float v = s[i]; const float e = (v > -1e29f) ? __builtin_amdgcn_exp2f(v - m) : 0.f; s[i] = e; sum += e; }
        sum = wave_sum(sum);
        const float inv = 1.0f / fmaxf(sum, 1e-30f);
        for (int i = lane; i < n; i += 64) s[i] *= inv;
    }
}
__device__ __forceinline__ void attn_task(Frame& F, int l, int path, int b, int g, int t) {
    const int tid = F.tid, lane = F.lane, wid = F.wave;
    const int past = path ? 16384 : 0;
    const int row = path ? (MP + b * 8 + t) : (b * SEQ + t);
    const int pos = past + t, cur = pos >> 6;
    const int n_blk = path ? 257 : 64;
    LAS float* q = (LAS float*)(F.lds + RING_OFF);
    LAS float* S = q + 256;
    volatile LAS float* score = S + 4096;
    volatile LAS int* sel = (volatile LAS int*)(S + 4096 + 272);
    LAS float* red = S + 4096 + 272 + 16;
    __syncthreads();
    if (tid < 256) q[tid] = bf2f(((const bf16*)(F.ws + WS_Q))[(size_t)row * 1024 + g * 256 + tid]);
    __syncthreads();
    for (int idx = tid; idx < 4 * n_blk; idx += NWAVES * 64) {
        const int r = idx / n_blk, n = idx - r * n_blk;
        float s = -1e30f;
        if (n * 64 + 63 <= pos) { float a = 0.f; const LAS float* qq = q + r * 64;
            if (path) { const float* k = (const float*)(F.ws + WS_KCS) + (((size_t)l * 8 + b) * 256 + n) * 512 + g * 64;
#pragma unroll 8
                for (int d = 0; d < 64; ++d) a = fmaf(qq[d], k[d], a); }
            else { const bf16* k = (const bf16*)(F.ws + WS_KCP) + ((size_t)b * 64 + n) * 512 + g * 64;
#pragma unroll 8
                for (int d = 0; d < 64; ++d) a = fmaf(qq[d], bf2f(k[d]), a); }
            s = a; }
        S[r * 1024 + n] = s;
    }
    __syncthreads();
    softmax_rows(S, n_blk, wid, lane);
    __syncthreads();
    for (int n = tid; n < n_blk; n += NWAVES * 64) {
        const float imp = (S[n] + S[1024 + n]) + (S[2048 + n] + S[3072 + n]);
        const bool forced = (n == 0) || (n == cur) || (n == cur - 1);
        score[n] = forced ? 1e9f : (n <= cur ? imp : -1e9f);
    }
    float o_cmp = 0.f;
    const int r_ = (tid >> 6) & 3, d_ = tid & 63;
    if (tid < 256) { const int nv = path ? 256 : 64;
        for (int n = 0; n < nv; ++n) { const float p = S[r_ * 1024 + n]; if (p != 0.f) {
            const float v = path ? ((const float*)(F.ws + WS_KCS))[(((size_t)l * 8 + b) * 256 + n) * 512 + 256 + g * 64 + d_] : bf2f(((const bf16*)(F.ws + WS_KCP))[((size_t)b * 64 + n) * 512 + 256 + g * 64 + d_]);
            o_cmp = fmaf(p, v, o_cmp); } } }
    __syncthreads();
    if (wid == 0) {
        for (int j = 0; j < 16; ++j) {
            float best = -3.0e38f; int bi = 0x7fffffff;
            for (int n = lane; n < n_blk; n += 64) { const float v = score[n]; if (v > best) { best = v; bi = n; } }
#pragma unroll
            for (int o = 1; o < 64; o <<= 1) { const float ov = __shfl_xor(best, o); const int oi = __shfl_xor(bi, o); if (ov > best || (ov == best && oi < bi)) { best = ov; bi = oi; } }
            if (lane == 0) { sel[j] = bi; score[bi] = -3.4e38f; }
            __builtin_amdgcn_fence(__ATOMIC_RELEASE, "wavefront"); __builtin_amdgcn_wave_barrier(); __builtin_amdgcn_fence(__ATOMIC_ACQUIRE, "wavefront");
        }
    }
    __syncthreads();
    for (int kidx = tid; kidx < 1024; kidx += NWAVES * 64) {
        const int kpos = sel[kidx >> 6] * 64 + (kidx & 63);
        float s0 = -1e30f, s1 = -1e30f, s2 = -1e30f, s3 = -1e30f;
        if (kpos <= pos) { const KvRow kr = slc_row(F, l, path, b, kpos); dot4(q, kr, g * 64, s0, s1, s2, s3); }
        S[kidx] = s0; S[1024 + kidx] = s1; S[2048 + kidx] = s2; S[3072 + kidx] = s3;
    }
    __syncthreads();
    softmax_rows(S, 1024, wid, lane);
    __syncthreads();
    float o_sel;
    { float a0 = 0.f, a1 = 0.f, a2 = 0.f, a3 = 0.f;
        for (int kidx = wid; kidx < 1024; kidx += NWAVES) { const float p0 = S[kidx], p1 = S[1024 + kidx], p2 = S[2048 + kidx], p3 = S[3072 + kidx];
            if (p0 != 0.f || p1 != 0.f || p2 != 0.f || p3 != 0.f) { const int kpos = sel[kidx >> 6] * 64 + (kidx & 63); const float v = kv_at(slc_row(F, l, path, b, kpos), 256 + g * 64 + lane);
                a0 = fmaf(p0, v, a0); a1 = fmaf(p1, v, a1); a2 = fmaf(p2, v, a2); a3 = fmaf(p3, v, a3); } }
        red[wid * 256 + lane] = a0; red[wid * 256 + 64 + lane] = a1; red[wid * 256 + 128 + lane] = a2; red[wid * 256 + 192 + lane] = a3;
        __syncthreads();
        float s = 0.f; if (tid < 256) { for (int k = 0; k < NWAVES; ++k) s += red[k * 256 + tid]; }
        o_sel = s; }
    __syncthreads();
    const int wp0 = path ? 15872 : 0;
    for (int i = tid; i < 512; i += NWAVES * 64) {
        const int kpos = pos - 511 + i;
        float s0 = -1e30f, s1 = -1e30f, s2 = -1e30f, s3 = -1e30f;
        if (kpos >= wp0) { const KvRow kr = win_row(F, l, path, b, kpos); dot4(q, kr, g * 64, s0, s1, s2, s3); }
        S[i] = s0; S[1024 + i] = s1; S[2048 + i] = s2; S[3072 + i] = s3;
    }
    __syncthreads();
    softmax_rows(S, 512, wid, lane);
    __syncthreads();
    { float a0 = 0.f, a1 = 0.f, a2 = 0.f, a3 = 0.f;
        for (int i = wid; i < 512; i += NWAVES) { const float p0 = S[i], p1 = S[1024 + i], p2 = S[2048 + i], p3 = S[3072 + i];
            if (p0 != 0.f || p1 != 0.f || p2 != 0.f || p3 != 0.f) { const float v = kv_at(win_row(F, l, path, b, pos - 511 + i), 256 + g * 64 + lane);
                a0 = fmaf(p0, v, a0); a1 = fmaf(p1, v, a1); a2 = fmaf(p2, v, a2); a3 = fmaf(p3, v, a3); } }
        red[wid * 256 + lane] = a0; red[wid * 256 + 64 + lane] = a1; red[wid * 256 + 128 + lane] = a2; red[wid * 256 + 192 + lane] = a3;
        __syncthreads();
        if (tid < 256) { float o_win = 0.f; for (int k = 0; k < NWAVES; ++k) o_win += red[k * 256 + tid];
            const float* gp = (const float*)(F.ws + WS_G) + (size_t)row * 48 + g * 12 + r_ * 3;
            const float val = gp[0] * o_cmp + gp[1] * o_sel + gp[2] * o_win;
            ((bf16*)(F.ws + WS_A2))[(size_t)row * D_MODEL + g * 256 + r_ * 64 + d_] = (bf16)f2bf(val); }
    }
}
__device__ __forceinline__ void attn_phase_scalar(Frame& F, int l) {
    const int ntask = (MP + MS) * 4;
    for (int task = F.vcu; task < ntask; task += F.G) {
        int path, b, t, g;
        if (task < MP * 4) { path = 0; g = task & 3; const int row = task >> 2; b = row >> 12; t = row & 4095; }
        else { path = 1; const int k = task - MP * 4; g = k & 3; const int row = k >> 2; b = row >> 3; t = row & 7; }
        attn_task(F, l, path, b, g, t);
    }
    __syncthreads();
}


namespace at {
typedef float f32x16 __attribute__((ext_vector_type(16)));
typedef short v4i16_t __attribute__((ext_vector_type(4)));
constexpr int KB_OFF = 0, VB_OFF = 16384, PC_OFF = 32768, PITCH = 68, IMP_OFF = PC_OFF + 4 * 64 * PITCH * 4, SELM_OFF = IMP_OFF + 64 * PITCH * 4, END_OFF = SELM_OFF + 512;
static_assert(END_OFF <= RING_BYTES, "attention LDS");
__device__ __forceinline__ int crow(int r, int hi) { return (r & 3) + 8 * (r >> 2) + 4 * hi; }
__device__ __forceinline__ v4i16_t vtr(const LAS unsigned char* p) { return __builtin_amdgcn_ds_read_tr16_b64_v4i16((LAS v4i16_t*)p); }
typedef float f32x2_t __attribute__((ext_vector_type(2))); typedef __bf16 bf16x2_t __attribute__((ext_vector_type(2)));
__device__ __forceinline__ unsigned cvtpk(float lo, float hi) { f32x2_t v = {lo, hi}; bf16x2_t b = __builtin_convertvector(v, bf16x2_t); return __builtin_bit_cast(unsigned, b); }

__device__ __forceinline__ void attn_unit(Frame& F, int b, int g, int qt) {
    const int lane = F.lane, w = F.wave, q32 = lane & 31, hi = lane >> 5, r = w >> 1, j = 32 * (w & 1) + q32;
    const int cur = qt, nwin = (cur < 8 ? cur : 8) + 1, nsel = cur + 1, NT = 1 + nsel + nwin;
    const size_t tok = (size_t)b * SEQ + 64 * qt + j;
    LAS unsigned char* L = F.lds + RING_OFF;
    bf16x8 qr[4];
    { const bf16* qp = (const bf16*)(F.ws + WS_Q) + tok * 1024 + g * 256 + r * 64 + hi * 8;
#pragma unroll
      for (int d0 = 0; d0 < 4; ++d0) qr[d0] = *(const GAS bf16x8*)(qp + 16 * d0); }
    float gate0, gate1, gate2;
    { const float* gp = (const float*)(F.ws + WS_G) + tok * 48 + g * 12 + r * 3; gate0 = gp[0]; gate1 = gp[1]; gate2 = gp[2]; }
    const bf16* kcp = (const bf16*)(F.ws + WS_KCP) + (size_t)b * 64 * 512;
    const bf16* kvs = (const bf16*)(F.ws + WS_KVS) + (size_t)b * SEQ * 512;
    const bf16* kvw = (const bf16*)(F.ws + WS_KVW) + (size_t)b * SEQ * 512;
    const int koff = lane * 512 + g * 64 + w * 8;
    const int voff = (16 * (w & 3) + (lane >> 2)) * 512 + 256 + g * 64 + (w >> 2) * 32 + (lane & 3) * 8;
    LAS unsigned char* kdst = L + KB_OFF + w * 1024 + lane * 16;
    LAS unsigned char* vdst = L + VB_OFF + w * 1024 + lane * 16;
    const LAS unsigned char* kread = L + KB_OFF + hi * 1024 + q32 * 16;
    const LAS unsigned char* vread = L + VB_OFF + ((lane >> 4) & 1) * 32 + (lane & 3) * 8 + (4 * hi + ((lane & 15) >> 2)) * 64;
#define AT_SRC(k, base, row0) do { if ((k) == 0) { base = kcp; row0 = 0; } else if ((k) <= nsel) { base = kvs; row0 = 64 * ((k) - 1); } else { base = kvw; row0 = 64 * (cur - nwin + 1 + ((k) - nsel - 1)); } } while (0)
    v4u kreg, vreg;
    { const bf16* base; int row0; AT_SRC(0, base, row0); kreg = *(const GAS v4u*)(base + (size_t)row0 * 512 + koff); vreg = *(const GAS v4u*)(base + (size_t)row0 * 512 + voff); }
    __syncthreads();
    *(LAS v4u*)kdst = kreg; *(LAS v4u*)vdst = vreg;
    __syncthreads();
    float m = -1e30f, lsum = 0.f;
    f32x16 o0, o1, f0, f1;
#pragma unroll
    for (int i = 0; i < 16; ++i) { o0[i] = 0.f; o1[i] = 0.f; f0[i] = 0.f; f1[i] = 0.f; }
    unsigned long long selm = ~0ull;
    for (int k = 0; k < NT; ++k) {
        const bool more = k + 1 < NT;
        if (more) { const bf16* base; int row0; AT_SRC(k + 1, base, row0); kreg = *(const GAS v4u*)(base + (size_t)row0 * 512 + koff); vreg = *(const GAS v4u*)(base + (size_t)row0 * 512 + voff); }
        int br, nt; bool last;
        if (k == 0) { br = 0; nt = 0; last = true; } else if (k <= nsel) { br = 1; nt = k - 1; last = (k == nsel); } else { br = 2; nt = cur - nwin + 1 + (k - nsel - 1); last = (k == NT - 1); }
        float neg = 0.f;
        if (br == 1) neg = ((selm >> nt) & 1ull) ? 0.f : -INFINITY;
        f32x16 p0, p1;
#pragma unroll
        for (int i = 0; i < 16; ++i) { p0[i] = neg; p1[i] = neg; }
        { const LAS unsigned char* kb = kread + (k & 1) * 8192;
#pragma unroll
          for (int d0 = 0; d0 < 4; ++d0) { const bf16x8 a0 = *(const LAS bf16x8*)(kb + d0 * 2048), a1 = *(const LAS bf16x8*)(kb + d0 * 2048 + 512);
              p0 = __builtin_amdgcn_mfma_f32_32x32x16_bf16(a0, qr[d0], p0, 0, 0, 0); p1 = __builtin_amdgcn_mfma_f32_32x32x16_bf16(a1, qr[d0], p1, 0, 0, 0); } }
        if (br == 0) {
#pragma unroll
            for (int i = 0; i < 16; ++i) { const int n = crow(i, hi); if (!(n < cur || (n == cur && j == 63))) p0[i] = -INFINITY; if (!(n + 32 < cur || (n + 32 == cur && j == 63))) p1[i] = -INFINITY; }
        } else if (nt == cur) {
#pragma unroll
            for (int i = 0; i < 16; ++i) { const int n = crow(i, hi); if (n > j) p0[i] = -INFINITY; if (n + 32 > j) p1[i] = -INFINITY; }
        } else if (br == 2 && nt == cur - 8) {
#pragma unroll
            for (int i = 0; i < 16; ++i) { const int n = crow(i, hi); if (n <= j) p0[i] = -INFINITY; if (n + 32 <= j) p1[i] = -INFINITY; }
        }
        float rm = fmaxf(p0[0], p1[0]);
#pragma unroll
        for (int i = 1; i < 16; ++i) rm = fmaxf(rm, fmaxf(p0[i], p1[i]));
        rm = fmaxf(rm, __shfl_xor(rm, 32));
        if (__any(rm > m)) { const float mn = fmaxf(m, rm), f = __builtin_amdgcn_exp2f(m - mn); lsum *= f; o0 = o0 * f; o1 = o1 * f; m = mn; }
        float ps = 0.f;
#pragma unroll
        for (int i = 0; i < 16; ++i) { p0[i] = __builtin_amdgcn_exp2f(p0[i] - m); p1[i] = __builtin_amdgcn_exp2f(p1[i] - m); ps += p0[i] + p1[i]; }
        lsum += ps;
        { bf16x8 pf[4];
#pragma unroll
          for (int s = 0; s < 2; ++s) { v4u a, c;
#pragma unroll
              for (int e = 0; e < 4; ++e) { a[e] = cvtpk(p0[8 * s + 2 * e], p0[8 * s + 2 * e + 1]); c[e] = cvtpk(p1[8 * s + 2 * e], p1[8 * s + 2 * e + 1]); }
              pf[s] = __builtin_bit_cast(bf16x8, a); pf[2 + s] = __builtin_bit_cast(bf16x8, c); }
          const LAS unsigned char* vb = vread + (k & 1) * 8192;
#pragma unroll
          for (int s = 0; s < 4; ++s) {
              const v4i16_t l0 = vtr(vb + s * 1024), h0 = vtr(vb + s * 1024 + 512), l1 = vtr(vb + 4096 + s * 1024), h1 = vtr(vb + 4096 + s * 1024 + 512);
              const bf16x8 v0 = (bf16x8){l0[0], l0[1], l0[2], l0[3], h0[0], h0[1], h0[2], h0[3]}, v1 = (bf16x8){l1[0], l1[1], l1[2], l1[3], h1[0], h1[1], h1[2], h1[3]};
              o0 = __builtin_amdgcn_mfma_f32_32x32x16_bf16(v0, pf[s], o0, 0, 0, 0); o1 = __builtin_amdgcn_mfma_f32_32x32x16_bf16(v1, pf[s], o1, 0, 0, 0); } }
        if (last) {
            const float lt = lsum + __shfl_xor(lsum, 32), inv = lt > 0.f ? 1.0f / lt : 0.f, sc = (br == 0 ? gate0 : (br == 1 ? gate1 : gate2)) * inv;
            f0 = f0 + o0 * sc; f1 = f1 + o1 * sc;
            if (br == 0 && cur >= 16) {
                LAS float* pc = (LAS float*)(L + PC_OFF) + (r * 64 + j) * PITCH + 4 * hi;
#pragma unroll
                for (int q4 = 0; q4 < 4; ++q4) { *(LAS f32x4*)(pc + 8 * q4) = (f32x4){p0[4 * q4] * inv, p0[4 * q4 + 1] * inv, p0[4 * q4 + 2] * inv, p0[4 * q4 + 3] * inv};
                    *(LAS f32x4*)(pc + 32 + 8 * q4) = (f32x4){p1[4 * q4] * inv, p1[4 * q4 + 1] * inv, p1[4 * q4 + 2] * inv, p1[4 * q4 + 3] * inv}; }
            }
            m = -1e30f; lsum = 0.f;
#pragma unroll
            for (int i = 0; i < 16; ++i) { o0[i] = 0.f; o1[i] = 0.f; }
        }
        if (more) { *(LAS v4u*)(kdst + ((k + 1) & 1) * 8192) = kreg; *(LAS v4u*)(vdst + ((k + 1) & 1) * 8192) = vreg; }
        __syncthreads();
        if (k == 0 && cur >= 16) {
            const int jj = F.tid >> 3, n0 = (F.tid & 7) * 8;
            { f32x4 s0 = {0.f, 0.f, 0.f, 0.f}, s1 = s0;
#pragma unroll
              for (int h = 0; h < 4; ++h) { const LAS float* pc = (const LAS float*)(L + PC_OFF) + (h * 64 + jj) * PITCH + n0; s0 += *(const LAS f32x4*)pc; s1 += *(const LAS f32x4*)(pc + 4); }
              LAS float* ip = (LAS float*)(L + IMP_OFF) + jj * PITCH + n0; *(LAS f32x4*)ip = s0; *(LAS f32x4*)(ip + 4) = s1; }
            __syncthreads();
            { const LAS float* ip = (const LAS float*)(L + IMP_OFF) + jj * PITCH;
              float mine[8]; int rank[8];
#pragma unroll
              for (int e = 0; e < 8; ++e) { mine[e] = ip[n0 + e]; rank[e] = 0; }
              for (int mm = 1; mm <= cur - 2; ++mm) { const float v = ip[mm];
#pragma unroll
                  for (int e = 0; e < 8; ++e) rank[e] += (v > mine[e] || (v == mine[e] && mm < n0 + e)) ? 1 : 0; }
              unsigned byte = 0;
#pragma unroll
              for (int e = 0; e < 8; ++e) { const int n = n0 + e; const bool sb = (n == 0) || (n == cur) || (n == cur - 1) || (n >= 1 && n <= cur - 2 && rank[e] < 13); byte |= (sb ? 1u : 0u) << e; }
              ((LAS unsigned char*)(L + SELM_OFF))[jj * 8 + (F.tid & 7)] = (unsigned char)byte; }
            __syncthreads();
            selm = *(const LAS unsigned long long*)(L + SELM_OFF + j * 8);
        }
    }
#undef AT_SRC
    { bf16* op = (bf16*)(F.ws + WS_A2) + tok * D_MODEL + g * 256 + r * 64 + 4 * hi;
#pragma unroll
      for (int rg = 0; rg < 4; ++rg) {
          *(GAS unsigned long long*)(op + 8 * rg) = (unsigned long long)cvtpk(f0[4 * rg], f0[4 * rg + 1]) | ((unsigned long long)cvtpk(f0[4 * rg + 2], f0[4 * rg + 3]) << 32);
          *(GAS unsigned long long*)(op + 32 + 8 * rg) = (unsigned long long)cvtpk(f1[4 * rg], f1[4 * rg + 1]) | ((unsigned long long)cvtpk(f1[4 * rg + 2], f1[4 * rg + 3]) << 32); } }
}
}

__device__ __forceinline__ void attn_phase(Frame& F, int l) {
    for (int u = F.vcu; u < 256; u += F.G) { const int bg = u >> 5, s = u & 31;
        at::attn_unit(F, bg >> 2, bg & 3, s);
        at::attn_unit(F, bg >> 2, bg & 3, 63 - s); }
    __syncthreads();
    for (int task = F.vcu; task < MS * 4; task += F.G) { const int g = task & 3, row = task >> 2; attn_task(F, l, 1, row >> 3, g, row & 7); }
    __syncthreads();
}

struct Args { const void* in[18]; float* out; unsigned char* ws; int ph_lo, ph_hi; };
__global__ void __launch_bounds__(NWAVES * 64, 2) nsa_fwd(Args args) {
    extern __shared__ __attribute__((aligned(16))) unsigned char lds[];
    Frame F;
    F.lds = (LAS unsigned char*)lds;
    F.MISC = (volatile LAS unsigned*)(F.lds + MISC_OFF);
    F.tid = threadIdx.x; F.lane = F.tid & 63; F.wave = __builtin_amdgcn_readfirstlane(F.tid >> 6);
    F.G = gridDim.x; { const int bx = blockIdx.x; F.vcu = (F.G % 8 == 0) ? (bx % 8) * (F.G / 8) + bx / 8 : bx; }
    F.ws = args.ws; F.out = args.out; F.ctl = (gu32*)(args.ws + WS_CTL);
    for (int u = F.tid; u < (LDS_BYTES - LDSCTL_OFF) / 4; u += NWAVES * 64) ((LAS unsigned*)(F.lds + LDSCTL_OFF))[u] = 0u;
    __syncthreads();
    F.tab = (volatile LAS unsigned long long*)(F.lds + TAB_OFF);
    if (F.tid < 18) F.tab[F.tid] = (unsigned long long)args.in[F.tid];
    __syncthreads();
    XcdBarrier bar; bar.bar = (unsigned*)(F.ctl + CW_BAR); bar.x = 0; bar.st = nullptr;
    if (!MK_SPLIT) { bar = xcd_barrier_post((unsigned*)(F.ctl + CW_BAR), F.MISC + 8); bar.x = (unsigned)__builtin_amdgcn_readfirstlane((int)bar.x); }
    const int lo = args.ph_lo, hi = args.ph_hi; (void)lo; (void)hi;
#if MK_SPLIT
#define IN(k) (lo <= (k) && (k) < hi)
#else
#define IN(k) true
#endif
#define FRESH() do { int t_ = threadIdx.x; asm volatile("" : "+v"(t_)); F.tid = t_; F.lane = t_ & 63; F.wave = __builtin_amdgcn_readfirstlane(t_ >> 6); \
        unsigned char* w_ = F.ws; float* o_ = F.out; asm volatile("" : "+s"(w_), "+s"(o_)); F.ws = w_; F.out = o_; \
        int bx_ = blockIdx.x, g_ = gridDim.x; asm volatile("" : "+s"(bx_), "+s"(g_)); F.bx = bx_; F.G = g_; F.vcu = (g_ % 8 == 0) ? (bx_ % 8) * (g_ / 8) + bx_ / 8 : bx_; } while (0)
#define XB ((bf16*)(F.ws + WS_XB))
#define HB ((bf16*)(F.ws + WS_HB))
#define A2 ((bf16*)(F.ws + WS_A2))
#define ACT ((bf16*)(F.ws + WS_ACT))
#define SEAM(k) do { if (IN(k) && IN((k) + 1)) { if (!MK_SPLIT) { XcdBarrier b2_ = bar; asm volatile("" : "+s"(b2_.x), "+s"(b2_.bar)); xcd_barrier(b2_); } } } while (0)

    if (IN(PH_PRO)) { FRESH(); p0_prologue(F); }
    SEAM(PH_PRO);
    for (int l = 0; l < DEPTH; ++l) {
        const int pb = 1 + PH_PER_LAYER * l;
        if (IN(pb + 0)) { FRESH();
            pg8::Gemm g{XB, (const bf16*)(F.ws + WS_WIN + l * SZ_WIN), MPAD, NIN, D_MODEL}; pg8::StaticOrder S; S.init(MPAD, NIN, F.G, F.bx);
            pg8::EpiInProj E{(bf16*)(F.ws + WS_Q), (bf16*)(F.ws + WS_KVC), (bf16*)(F.ws + WS_Z), (bf16*)(F.ws + WS_BG), (float*)(F.ws + WS_G), F.out, l};
            pg8::gemm_phase<pg8::EpiInProj, pg8::StaticOrder, true, true>(F.lds + RING_OFF, g, S, E);
        }
        SEAM(pb + 0);
        if (IN(pb + 1)) { FRESH(); cmp_prompt_phase(F, l); FRESH(); conv_phase(F, l); }
        SEAM(pb + 1);
        if (IN(pb + 2)) { FRESH(); attn_phase(F, l); }
        SEAM(pb + 2);
        if (IN(pb + 3)) { FRESH();
            pg8::Gemm g{A2, (const bf16*)(F.ws + WS_WOUT + l * SZ_WOUT), MP, D_MODEL, D_MODEL}; pg8::StaticOrder S; S.init(MP, D_MODEL, F.G, F.bx);
            pg8::EpiF32 E{(float*)(F.ws + WS_MIX), D_MODEL};
            pg8::gemm_phase<pg8::EpiF32, pg8::StaticOrder, true, true>(F.lds + RING_OFF, g, S, E);
            FRESH(); skinny_phase<0>(F, A2 + (size_t)MP * D_MODEL, D_MODEL, (const bf16*)(F.ws + WS_WOUT + l * SZ_WOUT), D_MODEL, D_MODEL, 16, (float*)(F.ws + WS_PARTO));
        }
        SEAM(pb + 3);
        if (IN(pb + 4)) {
            const float* rp = l == 0 ? INF_(I_XP) : (const float*)(F.ws + WS_XF); const float* rs = l == 0 ? INF_(I_XS) : (const float*)(F.ws + WS_XF) + (size_t)MP * D_MODEL;
            FRESH(); ln_phase(F, rp, rs, (const float*)(F.ws + WS_MIX), (const float*)(F.ws + WS_PARTO), 16, INF_(I_LN1G) + (size_t)l * D_MODEL, INF_(I_LN1B) + (size_t)l * D_MODEL,
                     (float*)(F.ws + WS_H), (float*)(F.ws + WS_H) + (size_t)MP * D_MODEL, HB);
        }
        SEAM(pb + 4);
        if (IN(pb + 5)) { FRESH();
            pg8::Gemm g{HB, (const bf16*)(F.ws + WS_W1 + l * SZ_W1), MP, D_FF, D_MODEL}; pg8::StaticOrder S; S.init(MP, D_FF, F.G, F.bx);
            pg8::EpiRelu2 E{ACT, D_FF};
            pg8::gemm_phase<pg8::EpiRelu2, pg8::StaticOrder, true, true>(F.lds + RING_OFF, g, S, E);
            FRESH(); skinny_phase<0>(F, HB + (size_t)MP * D_MODEL, D_MODEL, (const bf16*)(F.ws + WS_W1 + l * SZ_W1), D_FF, D_MODEL, 4, (float*)(F.ws + WS_PART1));
        }
        SEAM(pb + 5);
        if (IN(pb + 6)) { FRESH();
            pg8::Gemm g{ACT, (const bf16*)(F.ws + WS_W2 + l * SZ_W2), MP, D_MODEL, D_FF}; pg8::StaticOrder S; S.init(MP, D_MODEL, F.G, F.bx);
            pg8::EpiF32 E{(float*)(F.ws + WS_F), D_MODEL};
            pg8::gemm_phase<pg8::EpiF32, pg8::StaticOrder, true, true>(F.lds + RING_OFF, g, S, E);
            FRESH(); skinny_phase<1>(F, (const float*)(F.ws + WS_PART1), D_FF, (const bf16*)(F.ws + WS_W2 + l * SZ_W2), D_MODEL, D_FF, 16, (float*)(F.ws + WS_PART2));
        }
        SEAM(pb + 6);
        if (IN(pb + 7)) {
            float* yp = (l == DEPTH - 1) ? F.out + O0 : (float*)(F.ws + WS_XF); float* ys = (l == DEPTH - 1) ? F.out + O1 : (float*)(F.ws + WS_XF) + (size_t)MP * D_MODEL;
            FRESH(); ln_phase(F, (const float*)(F.ws + WS_H), (const float*)(F.ws + WS_H) + (size_t)MP * D_MODEL, (const float*)(F.ws + WS_F), (const float*)(F.ws + WS_PART2), 16,
                     INF_(I_LN2G) + (size_t)l * D_MODEL, INF_(I_LN2B) + (size_t)l * D_MODEL, yp, ys, XB);
        }
        SEAM(pb + 7);
    }
#undef IN
#undef SEAM
#undef XB
#undef HB
#undef A2
#undef ACT
}

extern "C" void kernel_launch(void* const* d_in, const int* in_sizes, int n_in, void* d_out, int out_size, void* d_ws, size_t ws_size, hipStream_t stream) {
    (void)in_sizes;
    static int grid = 0;
    if (grid == 0) {
        if (n_in != 18 || (size_t)out_size != OEND || ws_size < WS_END) { fprintf(stderr, "kernel_launch: unexpected problem shape (n_in %d out %d ws %zu need %zu)\n", n_in, out_size, ws_size, (size_t)WS_END); grid = -1; return; }
        int dev = 0, cus = 0, per_cu = 0;
        if (hipGetDevice(&dev) != hipSuccess || hipDeviceGetAttribute(&cus, hipDeviceAttributeMultiprocessorCount, dev) != hipSuccess) { grid = -1; return; }
        if (hipFuncSetAttribute((const void*)nsa_fwd, hipFuncAttributeMaxDynamicSharedMemorySize, LDS_BYTES) != hipSuccess) { fprintf(stderr, "kernel_launch: hipFuncSetAttribute failed\n"); grid = -1; return; }
        if (hipOccupancyMaxActiveBlocksPerMultiprocessor(&per_cu, (const void*)nsa_fwd, NWAVES * 64, LDS_BYTES) != hipSuccess || per_cu < 1) { fprintf(stderr, "kernel_launch: occupancy query says %d\n", per_cu); per_cu = 1; }
        (void)hipGetLastError();
        grid = cus;
    }
    if (grid < 0) return;
    if (hipMemsetAsync((char*)d_ws + WS_CTL, 0, CTL_ZERO_BYTES, stream) != hipSuccess) return;
    Args a{};
    for (int i = 0; i < 18; ++i) a.in[i] = d_in[i];
    a.out = (float*)d_out; a.ws = (unsigned char*)d_ws;
#if MK_SPLIT
    for (int p = 0; p < N_PHASES; ++p) { a.ph_lo = p; a.ph_hi = p + 1; hipLaunchKernelGGL(nsa_fwd, dim3(grid), dim3(NWAVES * 64), LDS_BYTES, stream, a); }
#else
    a.ph_lo = 0; a.ph_hi = N_PHASES;
    hipLaunchKernelGGL(nsa_fwd, dim3(grid), dim3(NWAVES * 64), LDS_BYTES, stream, a);
#endif
    const hipError_t le = hipPeekAtLastError();
    if (le != hipSuccess) fprintf(stderr, "kernel_launch: launch failed: %s\n", hipGetErrorName(le));
}
```

```cpp
#include <hip/hip_runtime.h>
#include <cstdio>
#include <cstdint>
namespace pg8 {
#define PG8_LAS __attribute__((address_space(3)))
typedef unsigned short bf16_t;
typedef short bf16x8 __attribute__((ext_vector_type(8)));
typedef float f32x4 __attribute__((ext_vector_type(4)));
typedef unsigned u32x4 __attribute__((ext_vector_type(4)));
constexpr int BM = 256, BK = 64, HALF = 128, HTB = HALF * BK * 2  , STAGE_BYTES = 8 * HTB, NXCD = 8, WGM = 8;

__host__ __device__ __forceinline__ int lds_byte(int r, int c) { const int st = (r >> 4) * 2 + (c >> 5), rr = r & 15, cc = c & 31, ob = rr * 64 + cc * 2; return st * 1024 + (ob ^ (((ob >> 9) & 1) << 5)); }
__host__ __device__ __forceinline__ void stage_rc(int b, int& R, int& C) { const int st = b / 1024, sb = b % 1024, swz = sb ^ (((sb >> 9) & 1) << 5); R = (st >> 1) * 16 + swz / 64; C = (st & 1) * 32 + (swz % 64) / 2; }
__host__ __device__ __forceinline__ int perm32(int rho) { const int n = rho >> 4, i = rho & 15; return 8 * (i >> 2) + 4 * n + (i & 3); }

struct Unit { int pm, pn; };
struct Gemm { const bf16_t* A; const bf16_t* Bt; int M, N, K; };

struct StaticOrder {
    int nM, nN, nwg, G, c;
    __host__ __device__ void init(int M, int N, int G_, int c_) { nM = M / BM; nN = N / BM; nwg = nM * nN; G = G_; c = c_; }
    __host__ __device__ bool next(int i, Unit& u) const {
        const long L = (long)i * G + c; if (L >= nwg) return false;
        int wgid = (int)L; { const int q = nwg / NXCD, r = nwg % NXCD, xcd = wgid % NXCD, off = wgid / NXCD; wgid = (xcd < r ? xcd * (q + 1) : r * (q + 1) + (xcd - r) * q) + off; }
        const int nig = WGM * nN, gid = wgid / nig, fm = gid * WGM, gsz = (nM - fm) < WGM ? (nM - fm) : WGM;
        u.pm = fm + ((wgid % nig) % gsz); u.pn = (wgid % nig) / gsz; return true;
    }
    __device__ __forceinline__ void a_ready(const Unit&) const {}
    __device__ __forceinline__ void done(const Unit&) const {}
};

__device__ __forceinline__ unsigned cvt_pk_bf16(float lo, float hi) { unsigned r; asm volatile("v_cvt_pk_bf16_f32 %0, %1, %2" : "=v"(r) : "v"(lo), "v"(hi)); return r; }
__device__ __forceinline__ u32x4 pack8(const f32x4 v0, const f32x4 v1) { u32x4 w; w.x = cvt_pk_bf16(v0[0], v0[1]); w.y = cvt_pk_bf16(v0[2], v0[3]); w.z = cvt_pk_bf16(v1[0], v1[1]); w.w = cvt_pk_bf16(v1[2], v1[3]); return w; }

constexpr int EP_MROWS = 8256, EP_MP = 8192;
constexpr float EP_C2 = 0.125f * 1.4426950408889634f;
constexpr size_t EO2 = 16908288, EO3 = 25296896, EO4 = 33685504, EO5 = 34734080, EO6 = 34742272, EO7 = 34807808, EO8 = 34873344, EO9 = 39067648;

struct EpiInProj {
    static constexpr bool PERM = true, AFTER_DRAIN = false;
    bf16_t* Q; bf16_t* KV;   bf16_t* Z; bf16_t* BG; float* G; float* out; int layer;
    __device__ __forceinline__ void operator()(const f32x4 (&acc)[2][2][4][2], const Unit& u, int wr, int wc, int fr, int fq) const {
        const int pn = u.pn;
        const int row0 = u.pm * BM + wr * 64 + fr;
        if (pn < 4) {
#pragma unroll
            for (int ai = 0; ai < 2; ++ai)
#pragma unroll
                for (int m = 0; m < 4; ++m) { const int row = row0 + ai * HALF + m * 16; if (row < EP_MROWS) {
                    bf16_t* dst = Q + (size_t)row * 1024 + pn * 256 + wc * 32 + 8 * fq;
#pragma unroll
                    for (int bj = 0; bj < 2; ++bj) *(u32x4*)(dst + bj * HALF) = pack8(acc[ai][bj][m][0] * EP_C2, acc[ai][bj][m][1] * EP_C2); } }
        } else if (pn < 10) {
            const int which = (pn - 4) >> 1, cbase = ((pn - 4) & 1) * 256 + wc * 32 + 8 * fq;
            bf16_t* kvb = KV + (size_t)which * ((size_t)8448 * 512);
#pragma unroll
            for (int ai = 0; ai < 2; ++ai)
#pragma unroll
                for (int m = 0; m < 4; ++m) { const int row = row0 + ai * HALF + m * 16; if (row < EP_MROWS) {
                    float* fo = nullptr;
                    if (row < EP_MP) { const int b = row >> 12, t = row & 4095;
                        if (which == 0) fo = out + EO2 + ((size_t)layer * EP_MP + row) * 512;
                        else if (which == 1) fo = out + EO3 + ((size_t)layer * EP_MP + row) * 512;
                        else if (t >= 3584) fo = out + EO4 + (((size_t)layer * 2 + b) * 512 + (t - 3584)) * 512;
                    } else { const int s = row - EP_MP, b = s >> 3, t = s & 7;
                        if (which == 0) fo = out + EO6 + ((size_t)layer * 64 + s) * 512;
                        else if (which == 1) fo = out + EO7 + ((size_t)layer * 64 + s) * 512;
                        else fo = out + EO8 + (((size_t)layer * 8 + b) * 512 + 504 + t) * 512; }
#pragma unroll
                    for (int bj = 0; bj < 2; ++bj) { const int c = cbase + bj * HALF;
                        *(u32x4*)(kvb + (size_t)row * 512 + c) = pack8(acc[ai][bj][m][0], acc[ai][bj][m][1]);
                        if (fo) { *(f32x4*)(fo + c) = acc[ai][bj][m][0]; *(f32x4*)(fo + c + 4) = acc[ai][bj][m][1]; } } } }
        } else if (pn < 18) {
            const int c = (pn - 10) * 128 + wc * 32 + 8 * fq;
#pragma unroll
            for (int ai = 0; ai < 2; ++ai)
#pragma unroll
                for (int m = 0; m < 4; ++m) { const int row = row0 + ai * HALF + m * 16; if (row < EP_MROWS) {
                    const f32x4 z0 = acc[ai][0][m][0] * acc[ai][1][m][0], z1 = acc[ai][0][m][1] * acc[ai][1][m][1];
                    *(u32x4*)(Z + (size_t)row * 1024 + c) = pack8(z0, z1);
                    float* so = nullptr;
                    if (row < EP_MP) { const int b = row >> 12, t = row & 4095; if (t >= 4094) so = out + EO5 + (((size_t)layer * 2 + b) * 2 + (t - 4094)) * 1024 + c; }
                    else { const int s = row - EP_MP, b = s >> 3, t = s & 7; if (t >= 6) so = out + EO9 + (((size_t)layer * 8 + b) * 2 + (t - 6)) * 1024 + c; }
                    if (so) { *(f32x4*)so = z0; *(f32x4*)(so + 4) = z1; } } }
        } else if (pn < 22) {
#pragma unroll
            for (int ai = 0; ai < 2; ++ai)
#pragma unroll
                for (int m = 0; m < 4; ++m) { const int row = row0 + ai * HALF + m * 16; if (row < EP_MROWS) {
                    bf16_t* dst = BG + (size_t)row * 1024 + (pn - 18) * 256 + wc * 32 + 8 * fq;
#pragma unroll
                    for (int bj = 0; bj < 2; ++bj) *(u32x4*)(dst + bj * HALF) = pack8(acc[ai][bj][m][0], acc[ai][bj][m][1]); } }
        } else {
            if (wc == 0 || (wc == 1 && fq < 2)) {
#pragma unroll
                for (int ai = 0; ai < 2; ++ai)
#pragma unroll
                    for (int m = 0; m < 4; ++m) { const int row = row0 + ai * HALF + m * 16; if (row < EP_MROWS) {
                        float* dst = G + (size_t)row * 48 + wc * 32 + 8 * fq;
#pragma unroll
                        for (int n = 0; n < 2; ++n) { const f32x4 v = acc[ai][0][m][n]; f32x4 s;
#pragma unroll
                            for (int e = 0; e < 4; ++e) s[e] = 1.0f / (1.0f + __expf(-v[e]));
                            *(f32x4*)(dst + 4 * n) = s; } } }
            }
        }
    }
};

struct EpiF32 {
    static constexpr bool PERM = false, AFTER_DRAIN = false;
    float* C; int ldc;
    __device__ __forceinline__ void operator()(const f32x4 (&acc)[2][2][4][2], const Unit& u, int wr, int wc, int fr, int fq) const {
        const int row0 = u.pm * BM + wr * 64 + fr, col0 = u.pn * BM + wc * 32 + 4 * fq;
#pragma unroll
        for (int ai = 0; ai < 2; ++ai)
#pragma unroll
            for (int m = 0; m < 4; ++m) { float* rowp = C + (size_t)(row0 + ai * HALF + m * 16) * ldc + col0;
#pragma unroll
                for (int bj = 0; bj < 2; ++bj)
#pragma unroll
                    for (int n = 0; n < 2; ++n) *(f32x4*)(rowp + bj * HALF + n * 16) = acc[ai][bj][m][n]; }
    }
};

struct EpiRelu2 {
    static constexpr bool PERM = true, AFTER_DRAIN = false;
    bf16_t* O; int ldc;
    __device__ __forceinline__ void operator()(const f32x4 (&acc)[2][2][4][2], const Unit& u, int wr, int wc, int fr, int fq) const {
        const int row0 = u.pm * BM + wr * 64 + fr, col0 = u.pn * BM + wc * 32 + 8 * fq;
#pragma unroll
        for (int ai = 0; ai < 2; ++ai)
#pragma unroll
            for (int m = 0; m < 4; ++m) { bf16_t* rowp = O + (size_t)(row0 + ai * HALF + m * 16) * ldc + col0;
#pragma unroll
                for (int bj = 0; bj < 2; ++bj) { f32x4 v0 = acc[ai][bj][m][0], v1 = acc[ai][bj][m][1];
#pragma unroll
                    for (int e = 0; e < 4; ++e) { const float a = fmaxf(v0[e], 0.f), b = fmaxf(v1[e], 0.f); v0[e] = a * a; v1[e] = b * b; }
                    *(u32x4*)(rowp + bj * HALF) = pack8(v0, v1); } }
    }
};

template <class Epi, class Sched, bool ALIGN_EPI = false, bool SP2 = false>
__device__ __forceinline__ void gemm_phase(PG8_LAS unsigned char* lds, const Gemm g, const Sched& S, const Epi& E) {
    int tid_o = threadIdx.x; asm volatile("" : "+v"(tid_o));
    const int tid = tid_o, wid = __builtin_amdgcn_readfirstlane(tid >> 6), lane = tid & 63, wr = wid >> 2, wc = wid & 3, fr = lane & 15, fq = lane >> 4;
    const int K = g.K, nt = K / BK;
    unsigned voffA[2], voffB[2];
#pragma unroll
    for (int i = 0; i < 2; ++i) { int R, C; stage_rc(tid * 16 + i * 8192, R, C); const int Rb = Epi::PERM ? ((R & ~31) + perm32(R & 31)) : R;
        voffA[i] = (unsigned)(R * K + C) * 2u; voffB[i] = (unsigned)(Rb * K + C) * 2u; }
    const size_t kstep = (size_t)(BK * 2);
    const size_t hstep = (size_t)HALF * K * 2;
    const size_t tstep = 2 * hstep;
    const unsigned ldsw = (unsigned)wid * 1024u;
    const int aoff = lds_byte(wr * 64 + fr, fq * 8), boff = lds_byte(wc * 32 + fr, fq * 8);
#define PG8_SA(b, h) (((b) * 2 + (h)) * HTB)
#define PG8_SB(b, h) ((4 + (b) * 2 + (h)) * HTB)
#define PG8_STAGE(bufoff, gbase, voff) do { _Pragma("unroll") for (int _i = 0; _i < 2; ++_i) \
        __builtin_amdgcn_global_load_lds((const unsigned*)((const char*)(gbase) + (voff)[_i]), (PG8_LAS unsigned*)(lds + (bufoff) + ldsw + _i * 8192), 16, 0, 0); } while (0)
#define PG8_LDA(dst, b, h) do { _Pragma("unroll") for (int m = 0; m < 4; ++m) _Pragma("unroll") for (int k = 0; k < 2; ++k) dst[m][k] = *(const PG8_LAS bf16x8*)(lds + PG8_SA(b, h) + aoff + m * 2048 + k * 1024); } while (0)
#define PG8_LDB(dst, b, h) do { _Pragma("unroll") for (int n = 0; n < 2; ++n) _Pragma("unroll") for (int k = 0; k < 2; ++k) dst[n][k] = *(const PG8_LAS bf16x8*)(lds + PG8_SB(b, h) + boff + n * 2048 + k * 1024); } while (0)
#define PG8_MMA(ai, bj, At, Bt) do { __builtin_amdgcn_s_setprio(1); _Pragma("unroll") for (int m = 0; m < 4; ++m) _Pragma("unroll") for (int n = 0; n < 2; ++n) _Pragma("unroll") for (int k = 0; k < 2; ++k) \
        acc[ai][bj][m][n] = __builtin_amdgcn_mfma_f32_16x16x32_bf16(Bt[n][k], At[m][k], acc[ai][bj][m][n], 0, 0, 0); __builtin_amdgcn_s_setprio(0); } while (0)
#define PG8_WAIT_V(n) asm volatile("s_waitcnt vmcnt(" #n ")" ::: "memory")
#define PG8_WAIT_L(n) asm volatile("s_waitcnt lgkmcnt(" #n ")" ::: "memory")
#define PG8_BAR __builtin_amdgcn_s_barrier()
#define PG8_SCHED __builtin_amdgcn_sched_barrier(0)
    Unit cur, nxt; int ui = 0;
    if (!S.next(0, cur)) return;
    f32x4 acc[2][2][4][2];
#pragma unroll
    for (int a = 0; a < 2; ++a)
#pragma unroll
        for (int b = 0; b < 2; ++b)
#pragma unroll
            for (int m = 0; m < 4; ++m)
#pragma unroll
                for (int n = 0; n < 2; ++n) acc[a][b][m][n] = (f32x4){0.f, 0.f, 0.f, 0.f};
    bf16x8 At[4][2], B0[2][2], B1[2][2];
    const char* cA = (const char*)g.A + (size_t)cur.pm * tstep; const char* cB = (const char*)g.Bt + (size_t)cur.pn * tstep;
    S.a_ready(cur);
    if constexpr (SP2) {
        PG8_STAGE(PG8_SB(0, 0), cB, voffB); PG8_STAGE(PG8_SB(0, 1), cB + hstep, voffB); PG8_STAGE(PG8_SA(0, 0), cA, voffA); PG8_STAGE(PG8_SA(0, 1), cA + hstep, voffA);
        if (wr == 1) PG8_BAR;
        PG8_WAIT_V(2); PG8_BAR;
        PG8_STAGE(PG8_SB(1, 0), cB + kstep, voffB); PG8_STAGE(PG8_SA(1, 0), cA + kstep, voffA); PG8_STAGE(PG8_SB(1, 1), cB + hstep + kstep, voffB);
        PG8_WAIT_V(6); PG8_BAR;
    } else {
        PG8_STAGE(PG8_SB(0, 0), cB, voffB); PG8_STAGE(PG8_SA(0, 0), cA, voffA); PG8_STAGE(PG8_SB(0, 1), cB + hstep, voffB); PG8_STAGE(PG8_SA(0, 1), cA + hstep, voffA);
        if (wr == 1) PG8_BAR;
        PG8_WAIT_V(4); PG8_BAR;
        PG8_STAGE(PG8_SB(1, 0), cB + kstep, voffB); PG8_STAGE(PG8_SA(1, 0), cA + kstep, voffA); PG8_STAGE(PG8_SB(1, 1), cB + hstep + kstep, voffB);
        PG8_WAIT_V(6); PG8_BAR;
    }
    for (;;) {
        const bool has_next = S.next(ui + 1, nxt);
        const char* nA = has_next ? (const char*)g.A + (size_t)nxt.pm * tstep : cA; const char* nB = has_next ? (const char*)g.Bt + (size_t)nxt.pn * tstep : cB;
        for (int t = 0; t < nt; t += 2) {
            const bool last = (t == nt - 2);
            const char* a1 = cA + (size_t)(t + 1) * kstep;
            const char* a2 = last ? nA : cA + (size_t)(t + 2) * kstep; const char* b2 = last ? nB : cB + (size_t)(t + 2) * kstep;
            const char* a3 = a2 + kstep; const char* b3 = b2 + kstep;
            if (last && has_next) S.a_ready(nxt);
            if constexpr (SP2) {
            PG8_LDB(B0, 0, 0); PG8_LDB(B1, 0, 1); PG8_SCHED; PG8_LDA(At, 0, 0); PG8_STAGE(PG8_SA(1, 1), a1 + hstep, voffA);
            PG8_WAIT_V(8); PG8_WAIT_L(0); PG8_BAR; PG8_MMA(0, 0, At, B0); PG8_MMA(0, 1, At, B1); PG8_BAR; PG8_SCHED;
            PG8_LDA(At, 0, 1); PG8_STAGE(PG8_SB(0, 0), b2, voffB); PG8_STAGE(PG8_SB(0, 1), b2 + hstep, voffB); PG8_STAGE(PG8_SA(0, 0), a2, voffA);
            PG8_WAIT_V(8); PG8_WAIT_L(0); PG8_BAR; PG8_MMA(1, 0, At, B0); PG8_MMA(1, 1, At, B1); PG8_BAR; PG8_SCHED;
            PG8_LDB(B0, 1, 0); PG8_LDB(B1, 1, 1); PG8_SCHED; PG8_LDA(At, 1, 0); PG8_STAGE(PG8_SA(0, 1), a2 + hstep, voffA);
            PG8_WAIT_V(8); PG8_WAIT_L(0); PG8_BAR; PG8_MMA(0, 0, At, B0); PG8_MMA(0, 1, At, B1); PG8_BAR; PG8_SCHED;
            PG8_LDA(At, 1, 1); PG8_STAGE(PG8_SB(1, 0), b3, voffB); PG8_STAGE(PG8_SB(1, 1), b3 + hstep, voffB); PG8_STAGE(PG8_SA(1, 0), a3, voffA);
            PG8_WAIT_V(8); PG8_WAIT_L(0); PG8_BAR; PG8_MMA(1, 0, At, B0); PG8_MMA(1, 1, At, B1); PG8_BAR; PG8_SCHED;
            } else {
            PG8_LDB(B0, 0, 0); PG8_SCHED; PG8_LDA(At, 0, 0); PG8_STAGE(PG8_SA(1, 1), a1 + hstep, voffA);
            PG8_WAIT_L(8); PG8_BAR; PG8_WAIT_L(0); PG8_MMA(0, 0, At, B0); PG8_BAR; PG8_SCHED;
            PG8_LDB(B1, 0, 1); PG8_STAGE(PG8_SB(0, 0), b2, voffB);
            PG8_BAR; PG8_WAIT_L(0); PG8_MMA(0, 1, At, B1); PG8_BAR;
            PG8_LDA(At, 0, 1); PG8_STAGE(PG8_SA(0, 0), a2, voffA);
            PG8_BAR; PG8_WAIT_L(0); PG8_MMA(1, 0, At, B0); PG8_BAR; PG8_SCHED;
            PG8_STAGE(PG8_SB(0, 1), b2 + hstep, voffB);
            PG8_WAIT_V(6); PG8_BAR; PG8_MMA(1, 1, At, B1); PG8_BAR;
            PG8_LDB(B0, 1, 0); PG8_SCHED; PG8_LDA(At, 1, 0); PG8_STAGE(PG8_SA(0, 1), a2 + hstep, voffA);
            PG8_WAIT_L(8); PG8_BAR; PG8_WAIT_L(0); PG8_MMA(0, 0, At, B0); PG8_BAR; PG8_SCHED;
            PG8_LDB(B1, 1, 1); PG8_STAGE(PG8_SB(1, 0), b3, voffB);
            PG8_BAR; PG8_WAIT_L(0); PG8_MMA(0, 1, At, B1); PG8_BAR;
            PG8_LDA(At, 1, 1); PG8_STAGE(PG8_SA(1, 0), a3, voffA);
            PG8_BAR; PG8_WAIT_L(0); PG8_MMA(1, 0, At, B0); PG8_BAR; PG8_SCHED;
            PG8_STAGE(PG8_SB(1, 1), b3 + hstep, voffB);
            PG8_WAIT_V(6); PG8_BAR; PG8_MMA(1, 1, At, B1); PG8_BAR;
            }
        }
        if constexpr (ALIGN_EPI) { if (wr == 0) PG8_BAR; }
        if constexpr (!Epi::AFTER_DRAIN) { E(acc, cur, wr, wc, fr, fq); S.done(cur); }
        if (!has_next) break;
#pragma unroll
        for (int a = 0; a < 2; ++a)
#pragma unroll
            for (int b = 0; b < 2; ++b)
#pragma unroll
                for (int m = 0; m < 4; ++m)
#pragma unroll
                    for (int n = 0; n < 2; ++n) acc[a][b][m][n] = (f32x4){0.f, 0.f, 0.f, 0.f};
        cur = nxt; cA = nA; cB = nB; ++ui;
        if constexpr (ALIGN_EPI) { if (wr == 1) PG8_BAR; }
    }
    PG8_WAIT_V(0);
    if constexpr (!ALIGN_EPI) { if (wr == 0) PG8_BAR; }
    PG8_BAR;
    if constexpr (Epi::AFTER_DRAIN) { E.fused(acc, cur, wr, wc, fr, fq, lds, wid, lane); S.done(cur); }
#undef PG8_SA
#undef PG8_SB
#undef PG8_STAGE
#undef PG8_LDA
#undef PG8_LDB
#undef PG8_MMA
#undef PG8_WAIT_V
#undef PG8_WAIT_L
#undef PG8_BAR
#undef PG8_SCHED
}
}
#define GAS __attribute__((address_space(1)))
#define LAS __attribute__((address_space(3)))
typedef unsigned short bf16;
typedef unsigned v4u __attribute__((ext_vector_type(4)));
typedef float f32x4 __attribute__((ext_vector_type(4)));
typedef short bf16x8 __attribute__((ext_vector_type(8)));
typedef GAS unsigned gu32;
typedef GAS unsigned long long gu64;
#define RLX_AGENT __ATOMIC_RELAXED, __HIP_MEMORY_SCOPE_AGENT
#define LDS_WAIT() asm volatile("s_waitcnt lgkmcnt(0)" ::: "memory")
#define VM_WAIT() asm volatile("s_waitcnt vmcnt(0)" ::: "memory")
__device__ __forceinline__ unsigned long long rt() { return __builtin_amdgcn_s_memrealtime(); }
__device__ __forceinline__ unsigned f2bf(float f) { unsigned u = __builtin_bit_cast(unsigned, f); return (u + 0x7fffu + ((u >> 16) & 1u)) >> 16; }
__device__ __forceinline__ unsigned pk2(float lo, float hi) { return f2bf(lo) | (f2bf(hi) << 16); }

#define XB_TMO      128
#define XB_XCNT(j)  (256  + 64 * (j))
#define XB_XSUB(j)  (1280 + 64 * (j))
#define XB_XGEN(j)  (2304 + 64 * (j))
#define XB_TOP      3328
#define XB_TOPGEN   3392
#define XCD_BAR_WORDS 3456
#define XB_SPIN_CAP (1u << 18)

__device__ __forceinline__ unsigned xb_ld(unsigned* p)              { return __hip_atomic_load(p, __ATOMIC_RELAXED, __HIP_MEMORY_SCOPE_AGENT); }
__device__ __forceinline__ unsigned xb_add(unsigned* p, unsigned v) { return __hip_atomic_fetch_add(p, v, __ATOMIC_RELAXED, __HIP_MEMORY_SCOPE_AGENT); }
__device__ __forceinline__ unsigned xb_xcc_id() { return (unsigned)__builtin_amdgcn_s_getreg((3 << 11) | 20) & 0xFu; }
#define XB_SPIN(cond, bar) do { unsigned _sp = 0; while (cond) { __builtin_amdgcn_s_sleep(1); \
    if ((++_sp & 255u) == 0u) { if (xb_ld(&(bar)[XB_TMO])) break; if (_sp > XB_SPIN_CAP) { atomicAdd(&(bar)[XB_TMO], 1u); break; } } } } while (0)

struct XcdBarrier {
    unsigned* bar; unsigned x;
    volatile LAS unsigned* st;
};

__device__ __forceinline__ XcdBarrier xcd_barrier_post(unsigned* bar, volatile LAS unsigned* st) {
    XcdBarrier b; b.bar = bar; b.x = xb_xcc_id(); b.st = st;
    if (threadIdx.x == 0) (void)xb_add(&bar[XB_XCNT(b.x)], 1u);
    return b;
}
__device__ __forceinline__ void xcd_barrier_complete(unsigned* bar, unsigned x, unsigned& nloc, unsigned& nx) {
    const unsigned G = gridDim.x * gridDim.y * gridDim.z;
    unsigned sum, cnt, mine, sp = 0u;
    for (;;) {
        sum = 0u; cnt = 0u; mine = 0u;
#pragma unroll
        for (unsigned j = 0; j < 16; ++j) { const unsigned c = xb_ld(&bar[XB_XCNT(j)]); sum += c; cnt += (c > 0u) ? 1u : 0u; mine = (j == x) ? c : mine; }
        if (sum == G) break;
        __builtin_amdgcn_s_sleep(1);
        if ((++sp & 255u) == 0u) { if (xb_ld(&bar[XB_TMO])) break; if (sp > XB_SPIN_CAP) { atomicAdd(&bar[XB_TMO], 1u); break; } }
    }
    nloc = mine > 0u ? mine : 1u; nx = cnt > 0u ? cnt : 1u;
}

__device__ __forceinline__ void xcd_barrier(const XcdBarrier& b) {
    asm volatile("s_waitcnt vmcnt(0)" ::: "memory");
    __syncthreads();
    if (threadIdx.x == 0) {
        unsigned* bar = b.bar;
        __builtin_amdgcn_s_waitcnt(0);
        unsigned nloc = b.st[0], nx = b.st[1];
        if (nloc == 0u) { xcd_barrier_complete(bar, b.x, nloc, nx); b.st[0] = nloc; b.st[1] = nx; }
        const unsigned old = xb_add(&bar[XB_XSUB(b.x)], 1u);
        const unsigned gen = old / nloc;
        if (old + 1u == (gen + 1u) * nloc) {
            __builtin_amdgcn_fence(__ATOMIC_RELEASE, "agent");
            asm volatile("s_waitcnt vmcnt(0)" ::: "memory");
            const unsigned og = xb_add(&bar[XB_TOP], 1u);
            const unsigned tg = og / nx;
            if (og + 1u == (tg + 1u) * nx) xb_add(&bar[XB_TOPGEN], 1u);
            else XB_SPIN(xb_ld(&bar[XB_TOPGEN]) == tg, bar);
            __builtin_amdgcn_fence(__ATOMIC_ACQUIRE, "agent");
            xb_add(&bar[XB_XGEN(b.x)], 1u);
            asm volatile("s_waitcnt vmcnt(0)" ::: "memory");
        } else {
            XB_SPIN(xb_ld(&bar[XB_XGEN(b.x)]) == gen, bar);
            __builtin_amdgcn_fence(__ATOMIC_ACQUIRE, "agent");
            asm volatile("s_waitcnt vmcnt(0)" ::: "memory");
        }
    }
    __syncthreads();
}


constexpr int NWAVES = 8;
constexpr int D_MODEL = 2048, SEQ = 4096, DEPTH = 2, D_FF = 8192, PROJ = 5680, NIN = 5888;
constexpr int MP = 8192, MS = 64, MROWS = MP + MS, MPAD = 8448;
constexpr int NBLK_P = 64;
constexpr float ALPHA = 1.41421356237309515f, LN_EPS = 1e-5f;
constexpr size_t O0 = 0, O1 = 16777216, O2 = 16908288, O3 = 25296896, O4 = 33685504, O5 = 34734080, O6 = 34742272, O7 = 34807808, O8 = 34873344, O9 = 39067648, OEND = 39100416;
constexpr int PH_PRO = 0, PH_PER_LAYER = 8, N_PHASES = 1 + PH_PER_LAYER * DEPTH;
#ifndef PROBE_J
#define PROBE_J -2
#define PROBE_N 1
#endif
#define NREP(j) ((PROBE_J == (j)) ? PROBE_N : 1)
#ifndef MK_SPLIT
#define MK_SPLIT 0
#endif

constexpr size_t al256(size_t x) { return (x + 255) & ~(size_t)255; }
constexpr size_t WS_CTL = 0, CTL_ZERO_BYTES = 1u << 20;
constexpr size_t SZ_WIN = (size_t)NIN * D_MODEL * 2, SZ_WOUT = (size_t)D_MODEL * D_MODEL * 2, SZ_W1 = (size_t)D_FF * D_MODEL * 2, SZ_W2 = SZ_W1;
constexpr size_t WS_WIN = CTL_ZERO_BYTES, WS_WOUT = WS_WIN + DEPTH * SZ_WIN, WS_W1 = WS_WOUT + DEPTH * SZ_WOUT, WS_W2 = WS_W1 + DEPTH * SZ_W1;
constexpr size_t WS_XB = WS_W2 + DEPTH * SZ_W2;
constexpr size_t WS_XF = WS_XB + (size_t)MPAD * D_MODEL * 2;
constexpr size_t WS_Q = WS_XF + (size_t)MPAD * D_MODEL * 4;
constexpr size_t WS_KVC = WS_Q + (size_t)MPAD * 1024 * 2;
constexpr size_t WS_KVS = WS_KVC + (size_t)MPAD * 512 * 2, WS_KVW = WS_KVS + (size_t)MPAD * 512 * 2;
constexpr size_t WS_G = WS_KVW + (size_t)MPAD * 512 * 2;
constexpr size_t WS_Z = al256(WS_G + (size_t)MPAD * 48 * 4);
constexpr size_t WS_BG = WS_Z + (size_t)MPAD * 1024 * 2;
constexpr size_t WS_A2 = WS_BG + (size_t)MPAD * 1024 * 2;
constexpr size_t WS_MIX = WS_A2 + (size_t)MPAD * D_MODEL * 2;
constexpr size_t WS_H = WS_MIX + (size_t)MPAD * D_MODEL * 4;
constexpr size_t WS_HB = WS_H + (size_t)MPAD * D_MODEL * 4;
constexpr size_t WS_ACT = WS_HB + (size_t)MPAD * D_MODEL * 2;
constexpr size_t WS_F = WS_ACT + (size_t)MP * D_FF * 2;
constexpr size_t WS_KCP = WS_F + (size_t)MP * D_MODEL * 4;
constexpr size_t WS_KCS = WS_KCP + (size_t)2 * NBLK_P * 512 * 2;
constexpr size_t WS_PARTO = WS_KCS + (size_t)DEPTH * 8 * 256 * 512 * 4;
constexpr size_t WS_PART1 = WS_PARTO + (size_t)16 * 64 * 2048 * 4;
constexpr size_t WS_PART2 = WS_PART1 + (size_t)4 * 64 * 8192 * 4;
constexpr size_t WS_END = WS_PART2 + (size_t)16 * 64 * 2048 * 4;
constexpr int CW_TMO = 0, CW_BAR = 4096;

constexpr int RING_OFF = 0, RING_BYTES = 131072;
constexpr int LDSCTL_OFF = 139264, MISC_OFF = LDSCTL_OFF + 320, TAB_OFF = LDSCTL_OFF + 1024;
constexpr int LDS_BYTES = 147456;

__device__ __forceinline__ float bf2f(unsigned short h) { return __uint_as_float((unsigned)h << 16); }

struct Frame {
    LAS unsigned char* lds;
    volatile LAS unsigned* MISC;
    gu32* ctl;
    int tid, lane, wave;
    int vcu, G, bx;
    unsigned char* ws;
    float* out;
    volatile LAS unsigned long long* tab;
};
__device__ __forceinline__ const void* in_ptr(const Frame& F, int i) {
    const unsigned long long v = F.tab[i];
    const unsigned lo = __builtin_amdgcn_readfirstlane((unsigned)v), hi = __builtin_amdgcn_readfirstlane((unsigned)(v >> 32));
    return (const void*)(((unsigned long long)hi << 32) | lo);
}
#define INF_(i) ((const float*)in_ptr(F, (i)))
enum { I_XP = 0, I_XS, I_CCMP, I_CSLC, I_CWIN, I_SCONV, I_PT, I_WIN, I_WCK, I_WCV, I_CONVW, I_WOUT, I_LN1G, I_LN1B, I_W1, I_W2, I_LN2G, I_LN2B };

__device__ __forceinline__ float wave_sum(float v) {
#pragma unroll
    for (int o = 1; o < 64; o <<= 1) v += __shfl_xor(v, o);
    return v;
}
__device__ __forceinline__ float wave_max(float v) {
#pragma unroll
    for (int o = 1; o < 64; o <<= 1) v = fmaxf(v, __shfl_xor(v, o));
    return v;
}

__device__ __forceinline__ void p0_transpose_item(const float* W, int ldn, int K, int src_col0, int ncols, bf16* WT, int dst_row0, LAS float* scr, int k0, int lane) {
    const int kq = lane >> 4, n4 = (lane & 15) * 4;
    f32x4 v[16];
#pragma unroll
    for (int j = 0; j < 16; ++j) v[j] = (n4 < ncols) ? *(const GAS f32x4*)(W + (size_t)(k0 + 4 * j + kq) * ldn + src_col0 + n4) : (f32x4){0.f, 0.f, 0.f, 0.f};
#pragma unroll
    for (int j = 0; j < 16; ++j) { LAS float* s = scr + (4 * j + kq) * 65 + n4; s[0] = v[j][0]; s[1] = v[j][1]; s[2] = v[j][2]; s[3] = v[j][3]; }
    LDS_WAIT(); asm volatile("" ::: "memory");
    const int c = lane & 7;
#pragma unroll
    for (int j = 0; j < 8; ++j) { const int n = (lane >> 3) + 8 * j; const LAS float* s = scr + (8 * c) * 65 + n;
        v4u o; o.x = pk2(s[0 * 65], s[1 * 65]); o.y = pk2(s[2 * 65], s[3 * 65]); o.z = pk2(s[4 * 65], s[5 * 65]); o.w = pk2(s[6 * 65], s[7 * 65]);
        *(GAS v4u*)(WT + (size_t)(dst_row0 + n) * K + k0 + 8 * c) = o; }
    LDS_WAIT(); asm volatile("" ::: "memory");
}
__device__ __forceinline__ void win_block_src(int rb, int& src, int& ncols) {
    ncols = 64;
    if (rb < 40) { src = rb * 64; return; }
    if (rb < 72) { const int i = (rb - 40) >> 2, wb = (rb - 40) & 3; src = (wb < 2) ? (2608 + 128 * i + 64 * wb) : (4656 + 128 * i + 64 * (wb - 2)); return; }
    if (rb < 88) { src = 3632 + (rb - 72) * 64; return; }
    if (rb == 88) { src = 2560; ncols = 48; return; }
    src = 0; ncols = 0;
}
__device__ __forceinline__ void p0_prologue(Frame& F) {
    LAS float* scr = (LAS float*)(F.lds + RING_OFF + F.wave * 16640);
    const int gw = F.vcu * NWAVES + F.wave, NGW = F.G * NWAVES;
    constexpr int I_IN = (NIN / 64) * (D_MODEL / 64), I_OUT = (D_MODEL / 64) * (D_MODEL / 64), I_1 = (D_FF / 64) * (D_MODEL / 64), I_2 = (D_MODEL / 64) * (D_FF / 64);
    constexpr int I_LAYER = I_IN + I_OUT + I_1 + I_2;
    for (int it = gw; it < DEPTH * I_LAYER; it += NGW) {
        const int l = it / I_LAYER; int r = it - l * I_LAYER;
        if (r < I_IN) { const int rb = r % (NIN / 64), kb = r / (NIN / 64); int src, nc; win_block_src(rb, src, nc);
            p0_transpose_item(INF_(I_WIN) + (size_t)l * D_MODEL * PROJ, PROJ, D_MODEL, src, nc, (bf16*)(F.ws + WS_WIN + l * SZ_WIN), rb * 64, scr, kb * 64, F.lane); continue; }
        r -= I_IN;
        if (r < I_OUT) { const int rb = r % (D_MODEL / 64), kb = r / (D_MODEL / 64);
            p0_transpose_item(INF_(I_WOUT) + (size_t)l * D_MODEL * D_MODEL, D_MODEL, D_MODEL, rb * 64, 64, (bf16*)(F.ws + WS_WOUT + l * SZ_WOUT), rb * 64, scr, kb * 64, F.lane); continue; }
        r -= I_OUT;
        if (r < I_1) { const int rb = r % (D_FF / 64), kb = r / (D_FF / 64);
            p0_transpose_item(INF_(I_W1) + (size_t)l * D_MODEL * D_FF, D_FF, D_MODEL, rb * 64, 64, (bf16*)(F.ws + WS_W1 + l * SZ_W1), rb * 64, scr, kb * 64, F.lane); continue; }
        r -= I_1;
        { const int rb = r % (D_MODEL / 64), kb = r / (D_MODEL / 64);
            p0_transpose_item(INF_(I_W2) + (size_t)l * D_FF * D_MODEL, D_MODEL, D_FF, rb * 64, 64, (bf16*)(F.ws + WS_W2 + l * SZ_W2), rb * 64, scr, kb * 64, F.lane); }
    }
    for (int m = gw; m < MPAD; m += NGW) {
        GAS unsigned long long* o8 = (GAS unsigned long long*)((bf16*)(F.ws + WS_XB) + (size_t)m * D_MODEL) + F.lane;
        if (m < MROWS) { const float* xr = (m < MP) ? INF_(I_XP) + (size_t)m * D_MODEL : INF_(I_XS) + (size_t)(m - MP) * D_MODEL;
#pragma unroll
            for (int j = 0; j < 8; ++j) { const f32x4 v = ((const GAS f32x4*)xr)[F.lane + 64 * j]; o8[64 * j] = (unsigned long long)pk2(v.x, v.y) | ((unsigned long long)pk2(v.z, v.w) << 32); }
        } else {
#pragma unroll
            for (int j = 0; j < 8; ++j) o8[64 * j] = 0ull; }
    }
    for (int it = gw; it < DEPTH * 8 * 256; it += NGW) {
        const int l = it >> 11, b = (it >> 8) & 7, n = it & 255;
        const int page = ((const int*)in_ptr(F, I_PT))[b * 128 + (n >> 1)];
        const float* src = INF_(I_CCMP) + (((size_t)l * 1280 + page) * 128 + (n & 1) * 64) * 512 + F.lane * 8;
        const int kv = F.lane >> 5, d0 = (F.lane * 8) & 63;
        const float* w = (kv ? INF_(I_WCV) : INF_(I_WCK)) + (size_t)l * 4096 + d0;
        f32x4 a0 = {0.f, 0.f, 0.f, 0.f}, a1 = a0;
#pragma unroll 16
        for (int r = 0; r < 64; ++r) { const f32x4 v0 = *(const GAS f32x4*)(src + (size_t)r * 512), v1 = *(const GAS f32x4*)(src + (size_t)r * 512 + 4);
            const f32x4 w0 = *(const GAS f32x4*)(w + r * 64), w1 = *(const GAS f32x4*)(w + r * 64 + 4); a0 += v0 * w0; a1 += v1 * w1; }
        float* dst = (float*)(F.ws + WS_KCS) + (((size_t)l * 8 + b) * 256 + n) * 512 + F.lane * 8;
        *(GAS f32x4*)dst = a0; *(GAS f32x4*)(dst + 4) = a1;
    }
    { const size_t gt = (size_t)F.vcu * (NWAVES * 64) + F.tid, gs = (size_t)F.G * NWAVES * 64;
      for (size_t i = gt; i < (size_t)DEPTH * 8 * 504 * 128; i += gs) { const size_t lb = i / (504 * 128), rem = i - lb * (504 * 128);
          ((GAS f32x4*)(F.out + O8 + lb * 512 * 512))[rem] = ((const GAS f32x4*)(INF_(I_CWIN) + lb * 512 * 512 + 8 * 512))[rem]; } }
}

__device__ __forceinline__ void cmp_prompt_phase(Frame& F, int l) {
    const int gw = F.vcu * NWAVES + F.wave, NGW = F.G * NWAVES;
    for (int it = gw; it < 2 * NBLK_P; it += NGW) {
        const float* src = F.out + O2 + ((size_t)l * MP + (size_t)it * 64) * 512 + F.lane * 8;
        const int kv = F.lane >> 5, d0 = (F.lane * 8) & 63;
        const float* w = (kv ? INF_(I_WCV) : INF_(I_WCK)) + (size_t)l * 4096 + d0;
        f32x4 a0 = {0.f, 0.f, 0.f, 0.f}, a1 = a0;
#pragma unroll 8
        for (int r = 0; r < 64; ++r) { const f32x4 v0 = *(const GAS f32x4*)(src + (size_t)r * 512), v1 = *(const GAS f32x4*)(src + (size_t)r * 512 + 4);
            const f32x4 w0 = *(const GAS f32x4*)(w + r * 64), w1 = *(const GAS f32x4*)(w + r * 64 + 4); a0 += v0 * w0; a1 += v1 * w1; }
        v4u o; o.x = pk2(a0.x, a0.y); o.y = pk2(a0.z, a0.w); o.z = pk2(a1.x, a1.y); o.w = pk2(a1.z, a1.w);
        *(GAS v4u*)((bf16*)(F.ws + WS_KCP) + (size_t)it * 512 + F.lane * 8) = o;
    }
}
__device__ __forceinline__ void conv_phase(Frame& F, int l) {
    const bf16* Z = (const bf16*)(F.ws + WS_Z); const bf16* BG = (const bf16*)(F.ws + WS_BG); bf16* A2 = (bf16*)(F.ws + WS_A2);
    const float* cw = INF_(I_CONVW) + (size_t)l * 3 * 1024; const float* st = INF_(I_SCONV) + (size_t)l * 8 * 2 * 1024;
    const size_t gt = (size_t)F.vcu * (NWAVES * 64) + F.tid, gs = (size_t)F.G * NWAVES * 64;
    for (size_t i = gt; i < (size_t)MROWS * 128; i += gs) {
        const int row = (int)(i >> 7), c = (int)(i & 127) * 8;
        int path, b, t; if (row < MP) { path = 0; b = row >> 12; t = row & 4095; } else { path = 1; b = (row - MP) >> 3; t = (row - MP) & 7; }
        float z0[8], z1[8], z2[8], bg[8];
        { const v4u a = *(const GAS v4u*)(Z + (size_t)row * 1024 + c), g = *(const GAS v4u*)(BG + (size_t)row * 1024 + c);
#pragma unroll
          for (int e = 0; e < 4; ++e) { z0[2 * e] = __uint_as_float(a[e] << 16); z0[2 * e + 1] = __uint_as_float(a[e] & 0xffff0000u); bg[2 * e] = __uint_as_float(g[e] << 16); bg[2 * e + 1] = __uint_as_float(g[e] & 0xffff0000u); } }
        if (t >= 1) { const v4u a = *(const GAS v4u*)(Z + (size_t)(row - 1) * 1024 + c);
#pragma unroll
            for (int e = 0; e < 4; ++e) { z1[2 * e] = __uint_as_float(a[e] << 16); z1[2 * e + 1] = __uint_as_float(a[e] & 0xffff0000u); } }
        else {
#pragma unroll
            for (int e = 0; e < 8; ++e) z1[e] = path ? st[((size_t)b * 2 + 1) * 1024 + c + e] : 0.f; }
        if (t >= 2) { const v4u a = *(const GAS v4u*)(Z + (size_t)(row - 2) * 1024 + c);
#pragma unroll
            for (int e = 0; e < 4; ++e) { z2[2 * e] = __uint_as_float(a[e] << 16); z2[2 * e + 1] = __uint_as_float(a[e] & 0xffff0000u); } }
        else {
#pragma unroll
            for (int e = 0; e < 8; ++e) z2[e] = path ? st[((size_t)b * 2 + (t == 1 ? 1 : 0)) * 1024 + c + e] : 0.f; }
        float y[8];
#pragma unroll
        for (int e = 0; e < 8; ++e) y[e] = bg[e] * (cw[2 * 1024 + c + e] * z0[e] + cw[1024 + c + e] * z1[e] + cw[c + e] * z2[e]);
        v4u o; o.x = pk2(y[0], y[1]); o.y = pk2(y[2], y[3]); o.z = pk2(y[4], y[5]); o.w = pk2(y[6], y[7]);
        *(GAS v4u*)(A2 + (size_t)row * D_MODEL + 1024 + c) = o;
    }
}
__device__ __forceinline__ void ln_phase(Frame& F, const float* resid_p, const float* resid_s, const float* main_p, const float* parts, int nparts, const float* gam, const float* bet, float* of_p, float* of_s, bf16* ob) {
    const int gw = F.vcu * NWAVES + F.wave, NGW = F.G * NWAVES;
    for (int m = gw; m < MROWS; m += NGW) {
        const float* rr = (m < MP) ? resid_p + (size_t)m * D_MODEL : resid_s + (size_t)(m - MP) * D_MODEL;
        f32x4 v[8]; float s = 0.f;
#pragma unroll
        for (int j = 0; j < 8; ++j) { const f32x4 a = ((const GAS f32x4*)rr)[F.lane + 64 * j]; f32x4 c;
            if (m < MP) c = ((const GAS f32x4*)(main_p + (size_t)m * D_MODEL))[F.lane + 64 * j];
            else { c = (f32x4){0.f, 0.f, 0.f, 0.f}; for (int p = 0; p < nparts; ++p) c += ((const GAS f32x4*)(parts + ((size_t)p * 64 + (m - MP)) * D_MODEL))[F.lane + 64 * j]; }
            v[j] = a * ALPHA + c; s += (v[j].x + v[j].y) + (v[j].z + v[j].w); }
        const float mean = wave_sum(s) * (1.f / D_MODEL); float s2 = 0.f;
#pragma unroll
        for (int j = 0; j < 8; ++j) { v[j] = v[j] - mean; s2 += (v[j].x * v[j].x + v[j].y * v[j].y) + (v[j].z * v[j].z + v[j].w * v[j].w); }
        const float rstd = 1.0f / sqrtf(wave_sum(s2) * (1.f / D_MODEL) + LN_EPS);
        float* of = (m < MP) ? of_p + (size_t)m * D_MODEL : of_s + (size_t)(m - MP) * D_MODEL;
        GAS unsigned long long* o8 = (GAS unsigned long long*)(ob + (size_t)m * D_MODEL) + F.lane;
#pragma unroll
        for (int j = 0; j < 8; ++j) { const f32x4 gg = ((const GAS f32x4*)gam)[F.lane + 64 * j], bb = ((const GAS f32x4*)bet)[F.lane + 64 * j];
            const f32x4 y = v[j] * rstd * gg + bb;
            ((GAS f32x4*)of)[F.lane + 64 * j] = y;
            o8[64 * j] = (unsigned long long)pk2(y.x, y.y) | ((unsigned long long)pk2(y.z, y.w) << 32); }
    }
}

template <int AMODE>
__device__ __forceinline__ void skinny_phase(Frame& F, const void* Ap, int lda, const bf16* Bt, int N, int K, int KS, float* part) {
    const int ntile = N / 128, ntask = ntile * KS, klen = K / KS, pitch = klen + 8;
    const int fr = F.lane & 15, fq = F.lane >> 4;
    LAS bf16* As = (LAS bf16*)(F.lds + RING_OFF);
    for (int task = F.vcu; task < ntask; task += F.G) {
        const int nt = task % ntile, ks = task / ntile;
        const int n0 = nt * 128 + F.wave * 16, k0 = ks * klen;
        __syncthreads();
        for (int c = F.tid; c < 64 * (klen / 8); c += NWAVES * 64) {
            const int row = c / (klen / 8), kc = (c % (klen / 8)) * 8; v4u w;
            if (AMODE == 0) w = *(const GAS v4u*)((const bf16*)Ap + (size_t)row * lda + k0 + kc);
            else { const float* a = (const float*)Ap + (size_t)row * lda + k0 + kc; f32x4 s0 = {0.f, 0.f, 0.f, 0.f}, s1 = s0;
#pragma unroll
                for (int p = 0; p < 4; ++p) { s0 += *(const GAS f32x4*)(a + (size_t)p * 64 * lda); s1 += *(const GAS f32x4*)(a + (size_t)p * 64 * lda + 4); }
#pragma unroll
                for (int e = 0; e < 4; ++e) { const float u0 = fmaxf(s0[e], 0.f), u1 = fmaxf(s1[e], 0.f); s0[e] = u0 * u0; s1[e] = u1 * u1; }
                w.x = pk2(s0.x, s0.y); w.y = pk2(s0.z, s0.w); w.z = pk2(s1.x, s1.y); w.w = pk2(s1.z, s1.w); }
            *(LAS v4u*)(As + row * pitch + kc) = w; }
        __syncthreads();
        f32x4 acc[4];
#pragma unroll
        for (int mi = 0; mi < 4; ++mi) acc[mi] = (f32x4){0.f, 0.f, 0.f, 0.f};
        const bf16* bp = Bt + (size_t)(n0 + fr) * K + k0 + 8 * fq;
        const LAS bf16* ap = As + fr * pitch + 8 * fq;
#pragma unroll 4
        for (int kk = 0; kk < klen; kk += 32) {
            const bf16x8 bfrag = *(const GAS bf16x8*)(bp + kk);
#pragma unroll
            for (int mi = 0; mi < 4; ++mi) { const bf16x8 afrag = *(const LAS bf16x8*)(ap + 16 * mi * pitch + kk);
                acc[mi] = __builtin_amdgcn_mfma_f32_16x16x32_bf16(afrag, bfrag, acc[mi], 0, 0, 0); }
        }
#pragma unroll
        for (int mi = 0; mi < 4; ++mi)
#pragma unroll
            for (int r = 0; r < 4; ++r) part[((size_t)ks * 64 + 16 * mi + 4 * fq + r) * N + n0 + fr] = acc[mi][r];
    }
    __syncthreads();
}

struct KvRow { const float* f; const bf16* h; };
__device__ __forceinline__ float kv_at(const KvRow& r, int i) { return r.f ? r.f[i] : bf2f(r.h[i]); }
__device__ __forceinline__ KvRow slc_row(Frame& F, int l, int path, int b, int pos) {
    KvRow r; r.f = nullptr; r.h = nullptr;
    if (!path) r.h = (const bf16*)(F.ws + WS_KVS) + (size_t)(b * SEQ + pos) * 512;
    else if (pos < 16384) r.f = INF_(I_CSLC) + (((size_t)l * 1280 + ((const int*)in_ptr(F, I_PT))[b * 128 + (pos >> 7)]) * 128 + (pos & 127)) * 512;
    else r.h = (const bf16*)(F.ws + WS_KVS) + (size_t)(MP + b * 8 + (pos - 16384)) * 512;
    return r;
}
__device__ __forceinline__ KvRow win_row(Frame& F, int l, int path, int b, int pos) {
    KvRow r; r.f = nullptr; r.h = nullptr;
    if (!path) r.h = (const bf16*)(F.ws + WS_KVW) + (size_t)(b * SEQ + pos) * 512;
    else { const int i = pos - 15872;
        if (i < 512) r.f = INF_(I_CWIN) + (((size_t)l * 8 + b) * 512 + i) * 512;
        else r.h = (const bf16*)(F.ws + WS_KVW) + (size_t)(MP + b * 8 + (i - 512)) * 512; }
    return r;
}
__device__ __forceinline__ void dot4(const LAS float* q, const KvRow& r, int goff, float& s0, float& s1, float& s2, float& s3) {
    float a0 = 0.f, a1 = 0.f, a2 = 0.f, a3 = 0.f;
    if (r.f) {
#pragma unroll 4
        for (int i = 0; i < 16; ++i) { const f32x4 k = *(const GAS f32x4*)(r.f + goff + 4 * i);
#pragma unroll
            for (int e = 0; e < 4; ++e) { a0 = fmaf(q[4 * i + e], k[e], a0); a1 = fmaf(q[64 + 4 * i + e], k[e], a1); a2 = fmaf(q[128 + 4 * i + e], k[e], a2); a3 = fmaf(q[192 + 4 * i + e], k[e], a3); } }
    } else {
#pragma unroll 2
        for (int i = 0; i < 8; ++i) { const v4u w = *(const GAS v4u*)(r.h + goff + 8 * i);
#pragma unroll
            for (int e = 0; e < 4; ++e) { const float k0 = __uint_as_float(w[e] << 16), k1 = __uint_as_float(w[e] & 0xffff0000u); const int d = 8 * i + 2 * e;
                a0 = fmaf(q[d], k0, a0); a1 = fmaf(q[64 + d], k0, a1); a2 = fmaf(q[128 + d], k0, a2); a3 = fmaf(q[192 + d], k0, a3);
                a0 = fmaf(q[d + 1], k1, a0); a1 = fmaf(q[64 + d + 1], k1, a1); a2 = fmaf(q[128 + d + 1], k1, a2); a3 = fmaf(q[192 + d + 1], k1, a3); } }
    }
    s0 = a0; s1 = a1; s2 = a2; s3 = a3;
}
__device__ __forceinline__ void softmax_rows(LAS float* S, int n, int wid, int lane) {
    if (wid < 4) {
        LAS float* s = S + wid * 1024;
        float m = -1e30f;
        for (int i = lane; i < n; i += 64) m = fmaxf(m, s[i]);
        m = wave_max(m);
        float sum = 0.f;
        for (int i = lane; i < n; i += 64) { const float v = s[i]; const float e = (v > -1e29f) ? __builtin_amdgcn_exp2f(v - m) : 0.f; s[i] = e; sum += e; }
        sum = wave_sum(sum);
        const float inv = 1.0f / fmaxf(sum, 1e-30f);
        for (int i = lane; i < n; i += 64) s[i] *= inv;
    }
}
__device__ __forceinline__ void attn_task(Frame& F, int l, int path, int b, int g, int t) {
    const int tid = F.tid, lane = F.lane, wid = F.wave;
    const int past = path ? 16384 : 0;
    const int row = path ? (MP + b * 8 + t) : (b * SEQ + t);
    const int pos = past + t, cur = pos >> 6;
    const int n_blk = path ? 257 : 64;
    LAS float* q = (LAS float*)(F.lds + RING_OFF);
    LAS float* S = q + 256;
    volatile LAS float* score = S + 4096;
    volatile LAS int* sel = (volatile LAS int*)(S + 4096 + 272);
    LAS float* red = S + 4096 + 272 + 16;
    __syncthreads();
    if (tid < 256) q[tid] = bf2f(((const bf16*)(F.ws + WS_Q))[(size_t)row * 1024 + g * 256 + tid]);
    __syncthreads();
    for (int idx = tid; idx < 4 * n_blk; idx += NWAVES * 64) {
        const int r = idx / n_blk, n = idx - r * n_blk;
        float s = -1e30f;
        if (n * 64 + 63 <= pos) { float a = 0.f; const LAS float* qq = q + r * 64;
            if (path) { const float* k = (const float*)(F.ws + WS_KCS) + (((size_t)l * 8 + b) * 256 + n) * 512 + g * 64;
#pragma unroll 8
                for (int d = 0; d < 64; ++d) a = fmaf(qq[d], k[d], a); }
            else { const bf16* k = (const bf16*)(F.ws + WS_KCP) + ((size_t)b * 64 + n) * 512 + g * 64;
#pragma unroll 8
                for (int d = 0; d < 64; ++d) a = fmaf(qq[d], bf2f(k[d]), a); }
            s = a; }
        S[r * 1024 + n] = s;
    }
    __syncthreads();
    softmax_rows(S, n_blk, wid, lane);
    __syncthreads();
    for (int n = tid; n < n_blk; n += NWAVES * 64) {
        const float imp = (S[n] + S[1024 + n]) + (S[2048 + n] + S[3072 + n]);
        const bool forced = (n == 0) || (n == cur) || (n == cur - 1);
        score[n] = forced ? 1e9f : (n <= cur ? imp : -1e9f);
    }
    float o_cmp = 0.f;
    const int r_ = (tid >> 6) & 3, d_ = tid & 63;
    if (tid < 256) { const int nv = path ? 256 : 64;
        for (int n = 0; n < nv; ++n) { const float p = S[r_ * 1024 + n]; if (p != 0.f) {
            const float v = path ? ((const float*)(F.ws + WS_KCS))[(((size_t)l * 8 + b) * 256 + n) * 512 + 256 + g * 64 + d_] : bf2f(((const bf16*)(F.ws + WS_KCP))[((size_t)b * 64 + n) * 512 + 256 + g * 64 + d_]);
            o_cmp = fmaf(p, v, o_cmp); } } }
    __syncthreads();
    if (wid == 0) {
        for (int j = 0; j < 16; ++j) {
            float best = -3.0e38f; int bi = 0x7fffffff;
            for (int n = lane; n < n_blk; n += 64) { const float v = score[n]; if (v > best) { best = v; bi = n; } }
#pragma unroll
            for (int o = 1; o < 64; o <<= 1) { const float ov = __shfl_xor(best, o); const int oi = __shfl_xor(bi, o); if (ov > best || (ov == best && oi < bi)) { best = ov; bi = oi; } }
            if (lane == 0) { sel[j] = bi; score[bi] = -3.4e38f; }
            __builtin_amdgcn_fence(__ATOMIC_RELEASE, "wavefront"); __builtin_amdgcn_wave_barrier(); __builtin_amdgcn_fence(__ATOMIC_ACQUIRE, "wavefront");
        }
    }
    __syncthreads();
    for (int kidx = tid; kidx < 1024; kidx += NWAVES * 64) {
        const int kpos = sel[kidx >> 6] * 64 + (kidx & 63);
        float s0 = -1e30f, s1 = -1e30f, s2 = -1e30f, s3 = -1e30f;
        if (kpos <= pos) { const KvRow kr = slc_row(F, l, path, b, kpos); dot4(q, kr, g * 64, s0, s1, s2, s3); }
        S[kidx] = s0; S[1024 + kidx] = s1; S[2048 + kidx] = s2; S[3072 + kidx] = s3;
    }
    __syncthreads();
    softmax_rows(S, 1024, wid, lane);
    __syncthreads();
    float o_sel;
    { float a0 = 0.f, a1 = 0.f, a2 = 0.f, a3 = 0.f;
        for (int kidx = wid; kidx < 1024; kidx += NWAVES) { const float p0 = S[kidx], p1 = S[1024 + kidx], p2 = S[2048 + kidx], p3 = S[3072 + kidx];
            if (p0 != 0.f || p1 != 0.f || p2 != 0.f || p3 != 0.f) { const int kpos = sel[kidx >> 6] * 64 + (kidx & 63); const float v = kv_at(slc_row(F, l, path, b, kpos), 256 + g * 64 + lane);
                a0 = fmaf(p0, v, a0); a1 = fmaf(p1, v, a1); a2 = fmaf(p2, v, a2); a3 = fmaf(p3, v, a3); } }
        red[wid * 256 + lane] = a0; red[wid * 256 + 64 + lane] = a1; red[wid * 256 + 128 + lane] = a2; red[wid * 256 + 192 + lane] = a3;
        __syncthreads();
        float s = 0.f; if (tid < 256) { for (int k = 0; k < NWAVES; ++k) s += red[k * 256 + tid]; }
        o_sel = s; }
    __syncthreads();
    const int wp0 = path ? 15872 : 0;
    for (int i = tid; i < 512; i += NWAVES * 64) {
        const int kpos = pos - 511 + i;
        float s0 = -1e30f, s1 = -1e30f, s2 = -1e30f, s3 = -1e30f;
        if (kpos >= wp0) { const KvRow kr = win_row(F, l, path, b, kpos); dot4(q, kr, g * 64, s0, s1, s2, s3); }
        S[i] = s0; S[1024 + i] = s1; S[2048 + i] = s2; S[3072 + i] = s3;
    }
    __syncthreads();
    softmax_rows(S, 512, wid, lane);
    __syncthreads();
    { float a0 = 0.f, a1 = 0.f, a2 = 0.f, a3 = 0.f;
        for (int i = wid; i < 512; i += NWAVES) { const float p0 = S[i], p1 = S[1024 + i], p2 = S[2048 + i], p3 = S[3072 + i];
            if (p0 != 0.f || p1 != 0.f || p2 != 0.f || p3 != 0.f) { const float v = kv_at(win_row(F, l, path, b, pos - 511 + i), 256 + g * 64 + lane);
                a0 = fmaf(p0, v, a0); a1 = fmaf(p1, v, a1); a2 = fmaf(p2, v, a2); a3 = fmaf(p3, v, a3); } }
        red[wid * 256 + lane] = a0; red[wid * 256 + 64 + lane] = a1; red[wid * 256 + 128 + lane] = a2; red[wid * 256 + 192 + lane] = a3;
        __syncthreads();
        if (tid < 256) { float o_win = 0.f; for (int k = 0; k < NWAVES; ++k) o_win += red[k * 256 + tid];
            const float* gp = (const float*)(F.ws + WS_G) + (size_t)row * 48 + g * 12 + r_ * 3;
            const float val = gp[0] * o_cmp + gp[1] * o_sel + gp[2] * o_win;
            ((bf16*)(F.ws + WS_A2))[(size_t)row * D_MODEL + g * 256 + r_ * 64 + d_] = (bf16)f2bf(val); }
    }
}
__device__ __forceinline__ void attn_phase_scalar(Frame& F, int l) {
    const int ntask = (MP + MS) * 4;
    for (int task = F.vcu; task < ntask; task += F.G) {
        int path, b, t, g;
        if (task < MP * 4) { path = 0; g = task & 3; const int row = task >> 2; b = row >> 12; t = row & 4095; }
        else { path = 1; const int k = task - MP * 4; g = k & 3; const int row = k >> 2; b = row >> 3; t = row & 7; }
        attn_task(F, l, path, b, g, t);
    }
    __syncthreads();
}


namespace at {
typedef float f32x16 __attribute__((ext_vector_type(16)));
typedef short v4i16_t __attribute__((ext_vector_type(4)));
constexpr int KB_OFF = 0, VB_OFF = 16384, PC_OFF = 32768, PITCH = 68, IMP_OFF = PC_OFF + 4 * 64 * PITCH * 4, SELM_OFF = IMP_OFF + 64 * PITCH * 4, END_OFF = SELM_OFF + 512;
static_assert(END_OFF <= RING_BYTES, "attention LDS");
__device__ __forceinline__ int crow(int r, int hi) { return (r & 3) + 8 * (r >> 2) + 4 * hi; }
__device__ __forceinline__ v4i16_t vtr(const LAS unsigned char* p) { return __builtin_amdgcn_ds_read_tr16_b64_v4i16((LAS v4i16_t*)p); }
typedef float f32x2_t __attribute__((ext_vector_type(2))); typedef __bf16 bf16x2_t __attribute__((ext_vector_type(2)));
__device__ __forceinline__ unsigned cvtpk(float lo, float hi) { f32x2_t v = {lo, hi}; bf16x2_t b = __builtin_convertvector(v, bf16x2_t); return __builtin_bit_cast(unsigned, b); }

__device__ __forceinline__ void attn_unit(Frame& F, int b, int g, int qt) {
    const int lane = F.lane, w = F.wave, q32 = lane & 31, hi = lane >> 5, r = w >> 1, j = 32 * (w & 1) + q32;
    const int cur = qt, nwin = (cur < 8 ? cur : 8) + 1, nsel = cur + 1, NT = 1 + nsel + nwin;
    const size_t tok = (size_t)b * SEQ + 64 * qt + j;
    LAS unsigned char* L = F.lds + RING_OFF;
    bf16x8 qr[4];
    { const bf16* qp = (const bf16*)(F.ws + WS_Q) + tok * 1024 + g * 256 + r * 64 + hi * 8;
#pragma unroll
      for (int d0 = 0; d0 < 4; ++d0) qr[d0] = *(const GAS bf16x8*)(qp + 16 * d0); }
    float gate0, gate1, gate2;
    { const float* gp = (const float*)(F.ws + WS_G) + tok * 48 + g * 12 + r * 3; gate0 = gp[0]; gate1 = gp[1]; gate2 = gp[2]; }
    const bf16* kcp = (const bf16*)(F.ws + WS_KCP) + (size_t)b * 64 * 512;
    const bf16* kvs = (const bf16*)(F.ws + WS_KVS) + (size_t)b * SEQ * 512;
    const bf16* kvw = (const bf16*)(F.ws + WS_KVW) + (size_t)b * SEQ * 512;
    const int koff = lane * 512 + g * 64 + w * 8;
    const int voff = (16 * (w & 3) + (lane >> 2)) * 512 + 256 + g * 64 + (w >> 2) * 32 + (lane & 3) * 8;
    LAS unsigned char* kdst = L + KB_OFF + w * 1024 + lane * 16;
    LAS unsigned char* vdst = L + VB_OFF + w * 1024 + lane * 16;
    const LAS unsigned char* kread = L + KB_OFF + hi * 1024 + q32 * 16;
    const LAS unsigned char* vread = L + VB_OFF + ((lane >> 4) & 1) * 32 + (lane & 3) * 8 + (4 * hi + ((lane & 15) >> 2)) * 64;
#define AT_SRC(k, base, row0) do { if ((k) == 0) { base = kcp; row0 = 0; } else if ((k) <= nsel) { base = kvs; row0 = 64 * ((k) - 1); } else { base = kvw; row0 = 64 * (cur - nwin + 1 + ((k) - nsel - 1)); } } while (0)
    v4u kreg, vreg;
    { const bf16* base; int row0; AT_SRC(0, base, row0); kreg = *(const GAS v4u*)(base + (size_t)row0 * 512 + koff); vreg = *(const GAS v4u*)(base + (size_t)row0 * 512 + voff); }
    __syncthreads();
    *(LAS v4u*)kdst = kreg; *(LAS v4u*)vdst = vreg;
    __syncthreads();
    float m = -1e30f, lsum = 0.f;
    f32x16 o0, o1, f0, f1;
#pragma unroll
    for (int i = 0; i < 16; ++i) { o0[i] = 0.f; o1[i] = 0.f; f0[i] = 0.f; f1[i] = 0.f; }
    unsigned long long selm = ~0ull;
    for (int k = 0; k < NT; ++k) {
        const bool more = k + 1 < NT;
        if (more) { const bf16* base; int row0; AT_SRC(k + 1, base, row0); kreg = *(const GAS v4u*)(base + (size_t)row0 * 512 + koff); vreg = *(const GAS v4u*)(base + (size_t)row0 * 512 + voff); }
        int br, nt; bool last;
        if (k == 0) { br = 0; nt = 0; last = true; } else if (k <= nsel) { br = 1; nt = k - 1; last = (k == nsel); } else { br = 2; nt = cur - nwin + 1 + (k - nsel - 1); last = (k == NT - 1); }
        float neg = 0.f;
        if (br == 1) neg = ((selm >> nt) & 1ull) ? 0.f : -INFINITY;
        f32x16 p0, p1;
#pragma unroll
        for (int i = 0; i < 16; ++i) { p0[i] = neg; p1[i] = neg; }
        { const LAS unsigned char* kb = kread + (k & 1) * 8192;
#pragma unroll
          for (int d0 = 0; d0 < 4; ++d0) { const bf16x8 a0 = *(const LAS bf16x8*)(kb + d0 * 2048), a1 = *(const LAS bf16x8*)(kb + d0 * 2048 + 512);
              p0 = __builtin_amdgcn_mfma_f32_32x32x16_bf16(a0, qr[d0], p0, 0, 0, 0); p1 = __builtin_amdgcn_mfma_f32_32x32x16_bf16(a1, qr[d0], p1, 0, 0, 0); } }
        if (br == 0) {
#pragma unroll
            for (int i = 0; i < 16; ++i) { const int n = crow(i, hi); if (!(n < cur || (n == cur && j == 63))) p0[i] = -INFINITY; if (!(n + 32 < cur || (n + 32 == cur && j == 63))) p1[i] = -INFINITY; }
        } else if (nt == cur) {
#pragma unroll
            for (int i = 0; i < 16; ++i) { const int n = crow(i, hi); if (n > j) p0[i] = -INFINITY; if (n + 32 > j) p1[i] = -INFINITY; }
        } else if (br == 2 && nt == cur - 8) {
#pragma unroll
            for (int i = 0; i < 16; ++i) { const int n = crow(i, hi); if (n <= j) p0[i] = -INFINITY; if (n + 32 <= j) p1[i] = -INFINITY; }
        }
        float rm = fmaxf(p0[0], p1[0]);
#pragma unroll
        for (int i = 1; i < 16; ++i) rm = fmaxf(rm, fmaxf(p0[i], p1[i]));
        rm = fmaxf(rm, __shfl_xor(rm, 32));
        if (__any(rm > m)) { const float mn = fmaxf(m, rm), f = __builtin_amdgcn_exp2f(m - mn); lsum *= f; o0 = o0 * f; o1 = o1 * f; m = mn; }
        float ps = 0.f;
#pragma unroll
        for (int i = 0; i < 16; ++i) { p0[i] = __builtin_amdgcn_exp2f(p0[i] - m); p1[i] = __builtin_amdgcn_exp2f(p1[i] - m); ps += p0[i] + p1[i]; }
        lsum += ps;
        { bf16x8 pf[4];
#pragma unroll
          for (int s = 0; s < 2; ++s) { v4u a, c;
#pragma unroll
              for (int e = 0; e < 4; ++e) { a[e] = cvtpk(p0[8 * s + 2 * e], p0[8 * s + 2 * e + 1]); c[e] = cvtpk(p1[8 * s + 2 * e], p1[8 * s + 2 * e + 1]); }
              pf[s] = __builtin_bit_cast(bf16x8, a); pf[2 + s] = __builtin_bit_cast(bf16x8, c); }
          const LAS unsigned char* vb = vread + (k & 1) * 8192;
#pragma unroll
          for (int s = 0; s < 4; ++s) {
              const v4i16_t l0 = vtr(vb + s * 1024), h0 = vtr(vb + s * 1024 + 512), l1 = vtr(vb + 4096 + s * 1024), h1 = vtr(vb + 4096 + s * 1024 + 512);
              const bf16x8 v0 = (bf16x8){l0[0], l0[1], l0[2], l0[3], h0[0], h0[1], h0[2], h0[3]}, v1 = (bf16x8){l1[0], l1[1], l1[2], l1[3], h1[0], h1[1], h1[2], h1[3]};
              o0 = __builtin_amdgcn_mfma_f32_32x32x16_bf16(v0, pf[s], o0, 0, 0, 0); o1 = __builtin_amdgcn_mfma_f32_32x32x16_bf16(v1, pf[s], o1, 0, 0, 0); } }
        if (last) {
            const float lt = lsum + __shfl_xor(lsum, 32), inv = lt > 0.f ? 1.0f / lt : 0.f, sc = (br == 0 ? gate0 : (br == 1 ? gate1 : gate2)) * inv;
            f0 = f0 + o0 * sc; f1 = f1 + o1 * sc;
            if (br == 0 && cur >= 16) {
                LAS float* pc = (LAS float*)(L + PC_OFF) + (r * 64 + j) * PITCH + 4 * hi;
#pragma unroll
                for (int q4 = 0; q4 < 4; ++q4) { *(LAS f32x4*)(pc + 8 * q4) = (f32x4){p0[4 * q4] * inv, p0[4 * q4 + 1] * inv, p0[4 * q4 + 2] * inv, p0[4 * q4 + 3] * inv};
                    *(LAS f32x4*)(pc + 32 + 8 * q4) = (f32x4){p1[4 * q4] * inv, p1[4 * q4 + 1] * inv, p1[4 * q4 + 2] * inv, p1[4 * q4 + 3] * inv}; }
            }
            m = -1e30f; lsum = 0.f;
#pragma unroll
            for (int i = 0; i < 16; ++i) { o0[i] = 0.f; o1[i] = 0.f; }
        }
        if (more) { *(LAS v4u*)(kdst + ((k + 1) & 1) * 8192) = kreg; *(LAS v4u*)(vdst + ((k + 1) & 1) * 8192) = vreg; }
        __syncthreads();
        if (k == 0 && cur >= 16) {
            const int jj = F.tid >> 3, n0 = (F.tid & 7) * 8;
            { f32x4 s0 = {0.f, 0.f, 0.f, 0.f}, s1 = s0;
#pragma unroll
              for (int h = 0; h < 4; ++h) { const LAS float* pc = (const LAS float*)(L + PC_OFF) + (h * 64 + jj) * PITCH + n0; s0 += *(const LAS f32x4*)pc; s1 += *(const LAS f32x4*)(pc + 4); }
              LAS float* ip = (LAS float*)(L + IMP_OFF) + jj * PITCH + n0; *(LAS f32x4*)ip = s0; *(LAS f32x4*)(ip + 4) = s1; }
            __syncthreads();
            { const LAS float* ip = (const LAS float*)(L + IMP_OFF) + jj * PITCH;
              float mine[8]; int rank[8];
#pragma unroll
              for (int e = 0; e < 8; ++e) { mine[e] = ip[n0 + e]; rank[e] = 0; }
              for (int mm = 1; mm <= cur - 2; ++mm) { const float v = ip[mm];
#pragma unroll
                  for (int e = 0; e < 8; ++e) rank[e] += (v > mine[e] || (v == mine[e] && mm < n0 + e)) ? 1 : 0; }
              unsigned byte = 0;
#pragma unroll
              for (int e = 0; e < 8; ++e) { const int n = n0 + e; const bool sb = (n == 0) || (n == cur) || (n == cur - 1) || (n >= 1 && n <= cur - 2 && rank[e] < 13); byte |= (sb ? 1u : 0u) << e; }
              ((LAS unsigned char*)(L + SELM_OFF))[jj * 8 + (F.tid & 7)] = (unsigned char)byte; }
            __syncthreads();
            selm = *(const LAS unsigned long long*)(L + SELM_OFF + j * 8);
        }
    }
#undef AT_SRC
    { bf16* op = (bf16*)(F.ws + WS_A2) + tok * D_MODEL + g * 256 + r * 64 + 4 * hi;
#pragma unroll
      for (int rg = 0; rg < 4; ++rg) {
          *(GAS unsigned long long*)(op + 8 * rg) = (unsigned long long)cvtpk(f0[4 * rg], f0[4 * rg + 1]) | ((unsigned long long)cvtpk(f0[4 * rg + 2], f0[4 * rg + 3]) << 32);
          *(GAS unsigned long long*)(op + 32 + 8 * rg) = (unsigned long long)cvtpk(f1[4 * rg], f1[4 * rg + 1]) | ((unsigned long long)cvtpk(f1[4 * rg + 2], f1[4 * rg + 3]) << 32); } }
}
}


namespace sm {
constexpr int Q_OFF = 0, S_OFF = 256, SC_OFF = 4352, SEL_OFF = 4624, RED_OFF = 4640, NEW_OFF = 6688, TAB_OFF_F = 8736;
__device__ __forceinline__ float dot64(const LAS float* q, const f32x4 (&k)[16]) {
    float a = 0.f;
#pragma unroll
    for (int i = 0; i < 16; ++i) { a = fmaf(q[4 * i], k[i][0], a); a = fmaf(q[4 * i + 1], k[i][1], a); a = fmaf(q[4 * i + 2], k[i][2], a); a = fmaf(q[4 * i + 3], k[i][3], a); }
    return a;
}
__device__ __forceinline__ void park_partial(LAS float* red, int wid, int lane, f32x4 (&acc)[4]) {
#pragma unroll
    for (int r = 0; r < 4; ++r)
#pragma unroll
        for (int e = 0; e < 4; ++e) { float v = acc[r][e]; v += __shfl_xor(v, 16); v += __shfl_xor(v, 32); acc[r][e] = v; }
    if (lane < 16) {
#pragma unroll
        for (int r = 0; r < 4; ++r) *(LAS f32x4*)(red + wid * 256 + r * 64 + lane * 4) = acc[r]; }
}
__device__ __forceinline__ void sample_task(Frame& F, int l, int b, int g, int t) {
    const int tid = F.tid, lane = F.lane, wid = F.wave;
    const int row = MP + b * 8 + t, pos = 16384 + t;
    LAS float* base = (LAS float*)(F.lds + RING_OFF);
    LAS float* q = base + Q_OFF; LAS float* S = base + S_OFF; volatile LAS float* score = base + SC_OFF; volatile LAS int* sel = (volatile LAS int*)(base + SEL_OFF);
    LAS float* red = base + RED_OFF; LAS float* NEW = base + NEW_OFF;
    volatile LAS unsigned long long* KB = (volatile LAS unsigned long long*)(base + TAB_OFF_F);
    const int r_ = (tid >> 6) & 3, d_ = tid & 63;
    const int sub = lane >> 4, d4 = (lane & 15) * 4;
    __syncthreads();
    if (tid < 256) q[tid] = bf2f(((const bf16*)(F.ws + WS_Q))[(size_t)row * 1024 + g * 256 + tid]);
    for (int i = tid; i < 2048; i += NWAVES * 64) { const int kind = i >> 10, tr = (i >> 7) & 7, c = i & 127;
        const bf16* src = (const bf16*)(F.ws + (kind ? WS_KVW : WS_KVS)) + (size_t)(MP + b * 8 + tr) * 512 + (c < 64 ? g * 64 + c : 256 + g * 64 + (c - 64));
        NEW[i] = bf2f(*src); }
    __syncthreads();
    const float* kcs = (const float*)(F.ws + WS_KCS) + ((size_t)l * 8 + b) * 256 * 512 + g * 64;
    { const int n = tid & 255, hp = tid >> 8; f32x4 k[16];
#pragma unroll
      for (int i = 0; i < 16; ++i) k[i] = *(const GAS f32x4*)(kcs + (size_t)n * 512 + 4 * i);
      S[(2 * hp) * 1024 + n] = dot64(q + (2 * hp) * 64, k); S[(2 * hp + 1) * 1024 + n] = dot64(q + (2 * hp + 1) * 64, k);
      if (tid < 4) S[tid * 1024 + 256] = -1e30f; }
    __syncthreads();
    softmax_rows(S, 257, wid, lane);
    __syncthreads();
    for (int n = tid; n < 257; n += NWAVES * 64) { const float imp = (S[n] + S[1024 + n]) + (S[2048 + n] + S[3072 + n]); score[n] = (n == 0 || n >= 255) ? 1e9f : imp; }
    { float a0 = 0.f, a1 = 0.f, a2 = 0.f, a3 = 0.f;
#pragma unroll 8
      for (int i = 0; i < 32; ++i) { const int n = 32 * wid + i; const float v = kcs[(size_t)n * 512 + 256 + lane];
          a0 = fmaf(S[n], v, a0); a1 = fmaf(S[1024 + n], v, a1); a2 = fmaf(S[2048 + n], v, a2); a3 = fmaf(S[3072 + n], v, a3); }
      red[wid * 256 + lane] = a0; red[wid * 256 + 64 + lane] = a1; red[wid * 256 + 128 + lane] = a2; red[wid * 256 + 192 + lane] = a3; }
    __syncthreads();
    float o_cmp = 0.f;
    if (tid < 256) { for (int k = 0; k < NWAVES; ++k) o_cmp += red[k * 256 + tid]; }
    if (wid == 0) {
        for (int j = 0; j < 16; ++j) {
            float best = -3.0e38f; int bi = 0x7fffffff;
            for (int n = lane; n < 257; n += 64) { const float v = score[n]; if (v > best) { best = v; bi = n; } }
#pragma unroll
            for (int o = 1; o < 64; o <<= 1) { const float ov = __shfl_xor(best, o); const int oi = __shfl_xor(bi, o); if (ov > best || (ov == best && oi < bi)) { best = ov; bi = oi; } }
            if (lane == 0) { sel[j] = bi; score[bi] = -3.4e38f; }
            __builtin_amdgcn_fence(__ATOMIC_RELEASE, "wavefront"); __builtin_amdgcn_wave_barrier(); __builtin_amdgcn_fence(__ATOMIC_ACQUIRE, "wavefront");
        }
        if (lane < 16) { const int blk = sel[lane]; int before = 0;
#pragma unroll
            for (int j = 0; j < 16; ++j) before += (j < lane && sel[j] == 256) ? 1 : 0;
            if (blk != 256) { const int page = ((const int*)in_ptr(F, I_PT))[b * 128 + (blk >> 1)];
                const float* kb = INF_(I_CSLC) + (((size_t)l * 1280 + page) * 128 + (blk & 1) * 64) * 512 + g * 64;
                KB[lane - before] = (unsigned long long)kb; } }
    }
    __syncthreads();
    for (int kidx = tid; kidx < 960; kidx += NWAVES * 64) {
        const float* kp = (const float*)KB[kidx >> 6] + (size_t)(kidx & 63) * 512; f32x4 k[16];
#pragma unroll
        for (int i = 0; i < 16; ++i) k[i] = *(const GAS f32x4*)(kp + 4 * i);
#pragma unroll
        for (int r = 0; r < 4; ++r) S[r * 1024 + kidx] = dot64(q + r * 64, k);
    }
    if (tid < 64) { const bool ok = tid <= t;
#pragma unroll
        for (int r = 0; r < 4; ++r) { float a = -1e30f; if (ok) { a = 0.f; for (int d = 0; d < 64; ++d) a = fmaf(q[r * 64 + d], NEW[tid * 128 + d], a); } S[r * 1024 + 960 + tid] = a; } }
    __syncthreads();
    softmax_rows(S, 1024, wid, lane);
    __syncthreads();
    { f32x4 acc[4];
#pragma unroll
      for (int r = 0; r < 4; ++r) acc[r] = (f32x4){0.f, 0.f, 0.f, 0.f};
#pragma unroll 6
      for (int i = 0; i < 30; ++i) { const int key = 120 * wid + 4 * i + sub;
          const f32x4 v = *(const GAS f32x4*)((const float*)KB[key >> 6] + (size_t)(key & 63) * 512 + 256 + d4);
#pragma unroll
          for (int r = 0; r < 4; ++r) acc[r] += v * S[r * 1024 + key]; }
      park_partial(red, wid, lane, acc); }
    __syncthreads();
    float o_sel = 0.f;
    if (tid < 256) { for (int k = 0; k < NWAVES; ++k) o_sel += red[k * 256 + tid];
        for (int tr = 0; tr <= t; ++tr) o_sel = fmaf(S[r_ * 1024 + 960 + tr], NEW[tr * 128 + 64 + d_], o_sel); }
    __syncthreads();
    const float* cw = INF_(I_CWIN) + (((size_t)l * 8 + b) * 512) * 512 + g * 64;
    const int nc = 511 - t;
    { const int i = tid; float s0, s1, s2, s3;
      if (i < nc) { const float* kp = cw + (size_t)(t + 1 + i) * 512; f32x4 k[16];
#pragma unroll
          for (int c = 0; c < 16; ++c) k[c] = *(const GAS f32x4*)(kp + 4 * c);
          s0 = dot64(q, k); s1 = dot64(q + 64, k); s2 = dot64(q + 128, k); s3 = dot64(q + 192, k);
      } else { const LAS float* kp = NEW + 1024 + (i - nc) * 128; s0 = s1 = s2 = s3 = 0.f;
          for (int d = 0; d < 64; ++d) { const float kv = kp[d]; s0 = fmaf(q[d], kv, s0); s1 = fmaf(q[64 + d], kv, s1); s2 = fmaf(q[128 + d], kv, s2); s3 = fmaf(q[192 + d], kv, s3); } }
      S[i] = s0; S[1024 + i] = s1; S[2048 + i] = s2; S[3072 + i] = s3; }
    __syncthreads();
    softmax_rows(S, 512, wid, lane);
    __syncthreads();
    { f32x4 acc[4];
#pragma unroll
      for (int r = 0; r < 4; ++r) acc[r] = (f32x4){0.f, 0.f, 0.f, 0.f};
#pragma unroll 8
      for (int i = 0; i < 16; ++i) { const int key = 64 * wid + 4 * i + sub; const bool ok = key < nc; const int kc = ok ? key : 0;
          const f32x4 v = *(const GAS f32x4*)(cw + (size_t)(t + 1 + kc) * 512 + 256 + d4);
#pragma unroll
          for (int r = 0; r < 4; ++r) acc[r] += v * (ok ? S[r * 1024 + key] : 0.f); }
      park_partial(red, wid, lane, acc); }
    __syncthreads();
    if (tid < 256) { float o_win = 0.f; for (int k = 0; k < NWAVES; ++k) o_win += red[k * 256 + tid];
        for (int tr = 0; tr <= t; ++tr) o_win = fmaf(S[r_ * 1024 + nc + tr], NEW[1024 + tr * 128 + 64 + d_], o_win);
        const float* gp = (const float*)(F.ws + WS_G) + (size_t)row * 48 + g * 12 + r_ * 3;
        const float val = gp[0] * o_cmp + gp[1] * o_sel + gp[2] * o_win;
        ((bf16*)(F.ws + WS_A2))[(size_t)row * D_MODEL + g * 256 + r_ * 64 + d_] = (bf16)f2bf(val); }
}
}

__device__ __forceinline__ void attn_phase(Frame& F, int l) {
    for (int u = F.vcu; u < 256; u += F.G) { const int bg = u >> 5, s = u & 31;
        at::attn_unit(F, bg >> 2, bg & 3, s);
        at::attn_unit(F, bg >> 2, bg & 3, 63 - s); }
    __syncthreads();
    for (int rep = 0; rep < NREP(12); ++rep)
    for (int task = F.vcu; task < MS * 4; task += F.G) { const int g = task & 3, row = task >> 2; sm::sample_task(F, l, row >> 3, g, row & 7); }
    __syncthreads();
}

struct Args { const void* in[18]; float* out; unsigned char* ws; int ph_lo, ph_hi; };
__global__ void __launch_bounds__(NWAVES * 64, 2) nsa_fwd(Args args) {
    extern __shared__ __attribute__((aligned(16))) unsigned char lds[];
    Frame F;
    F.lds = (LAS unsigned char*)lds;
    F.MISC = (volatile LAS unsigned*)(F.lds + MISC_OFF);
    F.tid = threadIdx.x; F.lane = F.tid & 63; F.wave = __builtin_amdgcn_readfirstlane(F.tid >> 6);
    F.G = gridDim.x; { const int bx = blockIdx.x; F.vcu = (F.G % 8 == 0) ? (bx % 8) * (F.G / 8) + bx / 8 : bx; }
    F.ws = args.ws; F.out = args.out; F.ctl = (gu32*)(args.ws + WS_CTL);
    for (int u = F.tid; u < (LDS_BYTES - LDSCTL_OFF) / 4; u += NWAVES * 64) ((LAS unsigned*)(F.lds + LDSCTL_OFF))[u] = 0u;
    __syncthreads();
    F.tab = (volatile LAS unsigned long long*)(F.lds + TAB_OFF);
    if (F.tid < 18) F.tab[F.tid] = (unsigned long long)args.in[F.tid];
    __syncthreads();
    XcdBarrier bar; bar.bar = (unsigned*)(F.ctl + CW_BAR); bar.x = 0; bar.st = nullptr;
    if (!MK_SPLIT) { bar = xcd_barrier_post((unsigned*)(F.ctl + CW_BAR), F.MISC + 8); bar.x = (unsigned)__builtin_amdgcn_readfirstlane((int)bar.x); }
    const int lo = args.ph_lo, hi = args.ph_hi; (void)lo; (void)hi;
#if MK_SPLIT
#define IN(k) (lo <= (k) && (k) < hi)
#else
#define IN(k) true
#endif
#define FRESH() do { int t_ = threadIdx.x; asm volatile("" : "+v"(t_)); F.tid = t_; F.lane = t_ & 63; F.wave = __builtin_amdgcn_readfirstlane(t_ >> 6); \
        unsigned char* w_ = F.ws; float* o_ = F.out; asm volatile("" : "+s"(w_), "+s"(o_)); F.ws = w_; F.out = o_; \
        int bx_ = blockIdx.x, g_ = gridDim.x; asm volatile("" : "+s"(bx_), "+s"(g_)); F.bx = bx_; F.G = g_; F.vcu = (g_ % 8 == 0) ? (bx_ % 8) * (g_ / 8) + bx_ / 8 : bx_; } while (0)
#define XB ((bf16*)(F.ws + WS_XB))
#define HB ((bf16*)(F.ws + WS_HB))
#define A2 ((bf16*)(F.ws + WS_A2))
#define ACT ((bf16*)(F.ws + WS_ACT))
#define SEAM(k) do { if (IN(k) && IN((k) + 1)) { if (!MK_SPLIT) { XcdBarrier b2_ = bar; asm volatile("" : "+s"(b2_.x), "+s"(b2_.bar)); xcd_barrier(b2_); } } } while (0)

    if (IN(PH_PRO)) { for (int rep = 0; rep < NREP(-1); ++rep) { FRESH(); p0_prologue(F); } }
    SEAM(PH_PRO);
    for (int l = 0; l < DEPTH; ++l) {
        const int pb = 1 + PH_PER_LAYER * l;
        if (IN(pb + 0)) for (int rep = 0; rep < NREP(0); ++rep) { FRESH();
            pg8::Gemm g{XB, (const bf16*)(F.ws + WS_WIN + l * SZ_WIN), MPAD, NIN, D_MODEL}; pg8::StaticOrder S; S.init(MPAD, NIN, F.G, F.bx);
            pg8::EpiInProj E{(bf16*)(F.ws + WS_Q), (bf16*)(F.ws + WS_KVC), (bf16*)(F.ws + WS_Z), (bf16*)(F.ws + WS_BG), (float*)(F.ws + WS_G), F.out, l};
            pg8::gemm_phase<pg8::EpiInProj, pg8::StaticOrder, true, true>(F.lds + RING_OFF, g, S, E);
        }
        SEAM(pb + 0);
        if (IN(pb + 1)) for (int rep = 0; rep < NREP(1); ++rep) { FRESH(); cmp_prompt_phase(F, l); FRESH(); conv_phase(F, l); }
        SEAM(pb + 1);
        if (IN(pb + 2)) for (int rep = 0; rep < NREP(2); ++rep) { FRESH(); attn_phase(F, l); }
        SEAM(pb + 2);
        if (IN(pb + 3)) for (int rep = 0; rep < NREP(3); ++rep) { FRESH();
            pg8::Gemm g{A2, (const bf16*)(F.ws + WS_WOUT + l * SZ_WOUT), MP, D_MODEL, D_MODEL}; pg8::StaticOrder S; S.init(MP, D_MODEL, F.G, F.bx);
            pg8::EpiF32 E{(float*)(F.ws + WS_MIX), D_MODEL};
            pg8::gemm_phase<pg8::EpiF32, pg8::StaticOrder, true, true>(F.lds + RING_OFF, g, S, E);
            FRESH(); skinny_phase<0>(F, A2 + (size_t)MP * D_MODEL, D_MODEL, (const bf16*)(F.ws + WS_WOUT + l * SZ_WOUT), D_MODEL, D_MODEL, 16, (float*)(F.ws + WS_PARTO));
        }
        SEAM(pb + 3);
        if (IN(pb + 4)) for (int rep = 0; rep < NREP(4); ++rep) {
            const float* rp = l == 0 ? INF_(I_XP) : (const float*)(F.ws + WS_XF); const float* rs = l == 0 ? INF_(I_XS) : (const float*)(F.ws + WS_XF) + (size_t)MP * D_MODEL;
            FRESH(); ln_phase(F, rp, rs, (const float*)(F.ws + WS_MIX), (const float*)(F.ws + WS_PARTO), 16, INF_(I_LN1G) + (size_t)l * D_MODEL, INF_(I_LN1B) + (size_t)l * D_MODEL,
                     (float*)(F.ws + WS_H), (float*)(F.ws + WS_H) + (size_t)MP * D_MODEL, HB);
        }
        SEAM(pb + 4);
        if (IN(pb + 5)) for (int rep = 0; rep < NREP(5); ++rep) { FRESH();
            pg8::Gemm g{HB, (const bf16*)(F.ws + WS_W1 + l * SZ_W1), MP, D_FF, D_MODEL}; pg8::StaticOrder S; S.init(MP, D_FF, F.G, F.bx);
            pg8::EpiRelu2 E{ACT, D_FF};
            pg8::gemm_phase<pg8::EpiRelu2, pg8::StaticOrder, true, true>(F.lds + RING_OFF, g, S, E);
            FRESH(); skinny_phase<0>(F, HB + (size_t)MP * D_MODEL, D_MODEL, (const bf16*)(F.ws + WS_W1 + l * SZ_W1), D_FF, D_MODEL, 4, (float*)(F.ws + WS_PART1));
        }
        SEAM(pb + 5);
        if (IN(pb + 6)) for (int rep = 0; rep < NREP(6); ++rep) { FRESH();
            pg8::Gemm g{ACT, (const bf16*)(F.ws + WS_W2 + l * SZ_W2), MP, D_MODEL, D_FF}; pg8::StaticOrder S; S.init(MP, D_MODEL, F.G, F.bx);
            pg8::EpiF32 E{(float*)(F.ws + WS_F), D_MODEL};
            pg8::gemm_phase<pg8::EpiF32, pg8::StaticOrder, true, true>(F.lds + RING_OFF, g, S, E);
            FRESH(); skinny_phase<1>(F, (const float*)(F.ws + WS_PART1), D_FF, (const bf16*)(F.ws + WS_W2 + l * SZ_W2), D_MODEL, D_FF, 16, (float*)(F.ws + WS_PART2));
        }
        SEAM(pb + 6);
        if (IN(pb + 7)) for (int rep = 0; rep < NREP(7); ++rep) {
            float* yp = (l == DEPTH - 1) ? F.out + O0 : (float*)(F.ws + WS_XF); float* ys = (l == DEPTH - 1) ? F.out + O1 : (float*)(F.ws + WS_XF) + (size_t)MP * D_MODEL;
            FRESH(); ln_phase(F, (const float*)(F.ws + WS_H), (const float*)(F.ws + WS_H) + (size_t)MP * D_MODEL, (const float*)(F.ws + WS_F), (const float*)(F.ws + WS_PART2), 16,
                     INF_(I_LN2G) + (size_t)l * D_MODEL, INF_(I_LN2B) + (size_t)l * D_MODEL, yp, ys, XB);
        }
        SEAM(pb + 7);
    }
#undef IN
#undef SEAM
#undef XB
#undef HB
#undef A2
#undef ACT
}

extern "C" void kernel_launch(void* const* d_in, const int* in_sizes, int n_in, void* d_out, int out_size, void* d_ws, size_t ws_size, hipStream_t stream) {
    (void)in_sizes;
    static int grid = 0;
    if (grid == 0) {
        if (n_in != 18 || (size_t)out_size != OEND || ws_size < WS_END) { fprintf(stderr, "kernel_launch: unexpected problem shape (n_in %d out %d ws %zu need %zu)\n", n_in, out_size, ws_size, (size_t)WS_END); grid = -1; return; }
        int dev = 0, cus = 0, per_cu = 0;
        if (hipGetDevice(&dev) != hipSuccess || hipDeviceGetAttribute(&cus, hipDeviceAttributeMultiprocessorCount, dev) != hipSuccess) { grid = -1; return; }
        if (hipFuncSetAttribute((const void*)nsa_fwd, hipFuncAttributeMaxDynamicSharedMemorySize, LDS_BYTES) != hipSuccess) { fprintf(stderr, "kernel_launch: hipFuncSetAttribute failed\n"); grid = -1; return; }
        if (hipOccupancyMaxActiveBlocksPerMultiprocessor(&per_cu, (const void*)nsa_fwd, NWAVES * 64, LDS_BYTES) != hipSuccess || per_cu < 1) { fprintf(stderr, "kernel_launch: occupancy query says %d\n", per_cu); per_cu = 1; }
        (void)hipGetLastError();
        grid = cus;
    }
    if (grid < 0) return;
    if (hipMemsetAsync((char*)d_ws + WS_CTL, 0, CTL_ZERO_BYTES, stream) != hipSuccess) return;
    Args a{};
    for (int i = 0; i < 18; ++i) a.in[i] = d_in[i];
    a.out = (float*)d_out; a.ws = (unsigned char*)d_ws;
#if MK_SPLIT
    for (int p = 0; p < N_PHASES; ++p) { a.ph_lo = p; a.ph_hi = p + 1; hipLaunchKernelGGL(nsa_fwd, dim3(grid), dim3(NWAVES * 64), LDS_BYTES, stream, a); }
#else
    a.ph_lo = 0; a.ph_hi = N_PHASES;
    hipLaunchKernelGGL(nsa_fwd, dim3(grid), dim3(NWAVES * 64), LDS_BYTES, stream, a);
#endif
    const hipError_t le = hipPeekAtLastError();
    if (le != hipSuccess) fprintf(stderr, "kernel_launch: launch failed: %s\n", hipGetErrorName(le));
}
```
